# Optimizing an MI355X kernel written in HIP

```python
import jax, jax.numpy as jnp
from jax import lax
import numpy as np

D_MODEL = 2048
BATCH = 2
SEQ = 8192
DEPTH = 4

CHUNK = 64
HEAD_DIM = 128
N_HEADS = D_MODEL // HEAD_DIM
Q_BLOCK = 128
POOL_WINDOWS = (2, 4, 8, 16)
N_POOL_GROUPS = len(POOL_WINDOWS)
POOL_GC = D_MODEL // N_POOL_GROUPS
N_EXPERTS = 16
N_EXPERT_GROUPS = 4
EXPERTS_PER_GROUP = N_EXPERTS // N_EXPERT_GROUPS
TOP_K = 2
D_EXPERT = D_MODEL // 4
N_FOX_LAYERS = (DEPTH + 1) // 2
N_POOL_LAYERS = DEPTH // 2
DEEPNORM_ALPHA = (2 * DEPTH) ** 0.25
DEEPNORM_BETA = (8 * DEPTH) ** -0.25
LN_EPS = 1e-5
NEG_INF = -1e30

kernel_name = "fox_pool_hybrid_moe_trunk"


def layer_norm(x, g, b):
    xf = x.astype(jnp.float32)
    mu = xf.mean(-1, keepdims=True)
    var = jnp.square(xf - mu).mean(-1, keepdims=True)
    y = (xf - mu) * lax.rsqrt(var + LN_EPS)
    return (y * g.astype(jnp.float32) + b.astype(jnp.float32)).astype(x.dtype)


def fox_attention(q, k, v, F):
    B, H, S, Dh = q.shape
    nb = S // Q_BLOCK
    scale = Dh ** -0.5
    pos = jnp.arange(S)
    qb = q.reshape(B, H, nb, Q_BLOCK, Dh).transpose(2, 0, 1, 3, 4)
    Fb = F.reshape(B, H, nb, Q_BLOCK).transpose(2, 0, 1, 3)
    pb = pos.reshape(nb, Q_BLOCK)

    def one_block(args):
        qi, Fi, pi = args
        s = jnp.einsum("bhqd,bhkd->bhqk", qi, k, preferred_element_type=jnp.float32) * scale
        s = s + Fi[..., :, None] - F[..., None, :]
        s = jnp.where(pi[:, None] >= pos[None, :], s, NEG_INF)
        p = jax.nn.softmax(s, axis=-1)
        return jnp.einsum("bhqk,bhkd->bhqd", p.astype(v.dtype), v)

    o = lax.map(one_block, (qb, Fb, pb))
    return o.transpose(1, 2, 0, 3, 4).reshape(B, H, S, Dh)


def fox_mixer(h, w_in, b_f, w_o):
    B, S, D = h.shape
    proj = h @ w_in
    q, k, v, f_logit = jnp.split(proj, [D, 2 * D, 3 * D], axis=-1)
    heads = lambda t: t.reshape(B, S, N_HEADS, HEAD_DIM).transpose(0, 2, 1, 3)
    log_f = jax.nn.log_sigmoid((f_logit + b_f).astype(jnp.float32))
    F = jnp.cumsum(log_f, axis=1).transpose(0, 2, 1)
    o = fox_attention(heads(q), heads(k), heads(v), F)
    return o.transpose(0, 2, 1, 3).reshape(B, S, D) @ w_o


def pool_mixer(h, w_grp, chan_scale):
    B, S, D = h.shape
    hf = h.astype(jnp.float32)
    cs0 = jnp.concatenate([jnp.zeros((B, 1, D), jnp.float32), jnp.cumsum(hf, axis=1)], axis=1)
    t1 = jnp.arange(1, S + 1, dtype=jnp.float32)[:, None]
    groups = []
    for g, w in enumerate(POOL_WINDOWS):
        sl = slice(g * POOL_GC, (g + 1) * POOL_GC)
        cg = cs0[:, :, sl]
        hi = cg[:, 1:]
        lo = jnp.concatenate([jnp.zeros((B, w - 1, POOL_GC), jnp.float32), cg[:, :S - w + 1]], axis=1)
        mean = (hi - lo) / jnp.minimum(t1, float(w))
        groups.append(mean - hf[:, :, sl])
    d = jnp.stack(groups, axis=2).astype(h.dtype)
    y = jnp.einsum("bsgc,gce->bsge", d, w_grp).reshape(B, S, D)
    return y * chan_scale


def shared_router_moe(h, router_w, router_b, w_gate, w_up, w_down):
    B, S, D = h.shape
    t = h.reshape(B * S, D)
    aff = jax.nn.sigmoid((t @ router_w).astype(jnp.float32))
    sel = (aff + router_b.astype(jnp.float32)).reshape(-1, N_EXPERT_GROUPS, EXPERTS_PER_GROUP)
    group_score = lax.top_k(sel, 2)[0].sum(-1)
    g_idx = jnp.argmax(group_score, axis=-1)
    in_group = jnp.take_along_axis(sel, g_idx[:, None, None], axis=1)[:, 0]
    _, l_idx = lax.top_k(in_group, TOP_K)
    e_idx = g_idx[:, None] * EXPERTS_PER_GROUP + l_idx
    wts = jnp.take_along_axis(aff, e_idx, axis=1)
    wts = wts / wts.sum(-1, keepdims=True)
    combine = jnp.einsum("tk,tke->te", wts, jax.nn.one_hot(e_idx, N_EXPERTS, dtype=jnp.float32))
    a = jnp.einsum("td,edf->tef", t, w_gate)
    u = jnp.einsum("td,edf->tef", t, w_up)
    hid = jax.nn.silu(a) * u * combine[:, :, None].astype(h.dtype)
    return jnp.einsum("tef,efd->td", hid, w_down).reshape(B, S, D)


def setup_inputs(seed: int = 0) -> dict:
    key = jax.random.key(seed)
    ks = jax.random.split(key, 16)
    nrm = lambda k, shape, s: jax.random.normal(k, shape, jnp.float32) * s
    D = D_MODEL
    d_in = 3 * D + N_HEADS
    col_scale = jnp.asarray(np.concatenate([np.ones(2 * D), np.full(D, DEEPNORM_BETA),
                                            np.full(N_HEADS, 0.1)]).astype(np.float32))
    return {
        "x": nrm(ks[0], (BATCH, SEQ, D), 1.0),
        "c": nrm(ks[1], (BATCH, D), 1.0),
        "ada_w": nrm(ks[2], (DEPTH, D, 6 * D), 0.1 * D ** -0.5),
        "ada_b": nrm(ks[3], (DEPTH, 6 * D), 0.01),
        "fox_w_in": nrm(ks[4], (N_FOX_LAYERS, D, d_in), D ** -0.5) * col_scale,
        "fox_b_f": 3.0 + nrm(ks[5], (N_FOX_LAYERS, N_HEADS), 0.5),
        "fox_w_o": nrm(ks[6], (N_FOX_LAYERS, D, D), DEEPNORM_BETA * D ** -0.5),
        "pool_w": nrm(ks[7], (N_POOL_LAYERS, N_POOL_GROUPS, POOL_GC, POOL_GC), DEEPNORM_BETA * POOL_GC ** -0.5),
        "pool_scale": 1.0 + nrm(ks[8], (N_POOL_LAYERS, D), 0.1),
        "router_w": nrm(ks[9], (D, N_EXPERTS), D ** -0.5),
        "router_b": nrm(ks[10], (N_EXPERTS,), 0.01),
        "moe_w_gate": nrm(ks[11], (DEPTH, N_EXPERTS, D, D_EXPERT), D ** -0.5),
        "moe_w_up": nrm(ks[12], (DEPTH, N_EXPERTS, D, D_EXPERT), D ** -0.5),
        "moe_w_down": nrm(ks[13], (DEPTH, N_EXPERTS, D_EXPERT, D), DEEPNORM_BETA * D_EXPERT ** -0.5),
        "ln_g": 1.0 + nrm(ks[14], (DEPTH, 2, D), 0.05),
        "ln_b": nrm(ks[15], (DEPTH, 2, D), 0.01),
    }


def reference(x, c, ada_w, ada_b, fox_w_in, fox_b_f, fox_w_o, pool_w, pool_scale,
              router_w, router_b, moe_w_gate, moe_w_up, moe_w_down, ln_g, ln_b):
    cond = jax.nn.silu(c)
    for i in range(DEPTH):
        mods = (cond @ ada_w[i] + ada_b[i])[:, None, :]
        sh_t, sc_t, g_t, sh_c, sc_c, g_c = jnp.split(mods, 6, axis=-1)
        h = x * (1.0 + sc_t) + sh_t
        if i % 2 == 0:
            j = i // 2
            y = fox_mixer(h, fox_w_in[j], fox_b_f[j], fox_w_o[j])
        else:
            j = i // 2
            y = pool_mixer(h, pool_w[j], pool_scale[j])
        x = layer_norm(DEEPNORM_ALPHA * x + (1.0 + g_t) * y, ln_g[i, 0], ln_b[i, 0])
        h = x * (1.0 + sc_c) + sh_c
        y = shared_router_moe(h, router_w, router_b, moe_w_gate[i], moe_w_up[i], moe_w_down[i])
        x = layer_norm(DEEPNORM_ALPHA * x + (1.0 + g_c) * y, ln_g[i, 1], ln_b[i, 1])
    return x
```

```cpp
#include <hip/hip_runtime.h>
#include <cstdint>
#include <cstdio>
#include <cstring>

#define DEVFI __device__ __forceinline__
typedef unsigned short bf16_t;
typedef float f32x4 __attribute__((ext_vector_type(4)));
typedef unsigned u32x4 __attribute__((ext_vector_type(4)));
typedef unsigned u32x2 __attribute__((ext_vector_type(2)));

constexpr int DM = 2048, NB = 2, SEQ = 8192, T = NB * SEQ, DEPTH = 4, NH = 16, HD = 128, NE = 16, DE = 512;
constexpr int NPG = 4, PGC = 512;
constexpr int DIN = 3 * DM + NH;
constexpr float ALPHA = 1.681792830507429f;
constexpr float LN_EPS = 1e-5f;
constexpr float LOG2E = 1.4426950408889634f;
constexpr float QSCALE = 0.08838834764831845f * 1.4426950408889634f;
constexpr int SLOT_ROWS = 2 * T + NE * 256;

constexpr size_t MiB = 1u << 20;
constexpr size_t WS_CTL   = 0;
constexpr size_t CTL_BYTES = 1 * MiB;
constexpr size_t WS_MODS  = 1 * MiB;
constexpr size_t WS_LOGF  = 2 * MiB;
constexpr size_t WS_F     = 3 * MiB;
constexpr size_t WS_QREC  = 4 * MiB;
constexpr size_t WS_KREC  = 8 * MiB;
constexpr size_t WS_E01   = 12 * MiB;
constexpr size_t WS_W01   = 13 * MiB;
constexpr size_t WS_POS   = 14 * MiB;
constexpr size_t WS_TOK   = 15 * MiB;
constexpr size_t WS_XRES  = 16 * MiB;
constexpr size_t WS_H     = 80 * MiB;
constexpr size_t WS_Q     = 144 * MiB;
constexpr size_t WS_K     = 208 * MiB;
constexpr size_t WS_V     = 272 * MiB;
constexpr size_t WS_O     = 336 * MiB;
constexpr size_t WS_Z     = 400 * MiB;
constexpr size_t WS_HID   = 464 * MiB;
constexpr size_t WS_OSLOT = 512 * MiB;
constexpr size_t WS_END   = 672 * MiB;
constexpr int CW_CNT = 1024;

DEVFI float bf2f(unsigned b) { return __uint_as_float(b << 16); }
DEVFI unsigned f2bf(float f) { unsigned u = __float_as_uint(f); return (u + 0x7fffu + ((u >> 16) & 1u)) >> 16; }
DEVFI unsigned pk2(float lo, float hi) { return f2bf(lo) | (f2bf(hi) << 16); }
DEVFI float wave_sum(float v) {
#pragma unroll
    for (int o = 1; o < 64; o <<= 1) v += __shfl_xor(v, o);
    return v;
}
DEVFI float silu_f(float a) { return a / (1.f + __expf(-a)); }

__global__ __launch_bounds__(256) void k_ada_naive(const float* __restrict__ c, const float* __restrict__ ada_w, const float* __restrict__ ada_b, float* __restrict__ mods) {
    const int idx = blockIdx.x * 256 + threadIdx.x;
    const int i = idx / (6 * DM), n = idx % (6 * DM);
    const float* w = ada_w + (size_t)i * DM * 6 * DM + n;
    float a0 = 0.f, a1 = 0.f;
    for (int k = 0; k < DM; ++k) {
        const float wv = w[(size_t)k * 6 * DM];
        a0 += silu_f(c[k]) * wv; a1 += silu_f(c[DM + k]) * wv;
    }
    const float bv = ada_b[(size_t)i * 6 * DM + n];
    mods[((size_t)i * 2 + 0) * 6 * DM + n] = a0 + bv;
    mods[((size_t)i * 2 + 1) * 6 * DM + n] = a1 + bv;
}

struct RowP {
    int mode;
    int last;
    int sk_kind;
    int wsk_ld;
    const float* xin; const bf16_t* Z; bf16_t* XRES; bf16_t* H; float* OUT; const bf16_t* OSLOT;
    const float* gamma; const float* beta;
    const float* sh; const float* sc;
    const float* gate;
    const float* Wsk; const float* bsk;
    float* LOGF; int* E01; float* W01; int* POS; int* CNT; int* TOK;
    const int* pE01; const int* pPOS; const int* pCNT;
};

DEVFI void load_vec32(const float* p, int lane, float (&v)[32]) {
#pragma unroll
    for (int j = 0; j < 4; ++j) {
        const f32x4 a = *(const f32x4*)(p + j * 512 + lane * 8), b = *(const f32x4*)(p + j * 512 + lane * 8 + 4);
        v[j * 8 + 0] = a[0]; v[j * 8 + 1] = a[1]; v[j * 8 + 2] = a[2]; v[j * 8 + 3] = a[3];
        v[j * 8 + 4] = b[0]; v[j * 8 + 5] = b[1]; v[j * 8 + 6] = b[2]; v[j * 8 + 7] = b[3];
    }
}
DEVFI void load_row_bf16(const bf16_t* p, int lane, float (&v)[32]) {
#pragma unroll
    for (int j = 0; j < 4; ++j) {
        const u32x4 a = *(const u32x4*)(p + j * 512 + lane * 8);
#pragma unroll
        for (int q = 0; q < 4; ++q) { v[j * 8 + 2 * q] = bf2f(a[q] & 0xffffu); v[j * 8 + 2 * q + 1] = bf2f(a[q] >> 16); }
    }
}
DEVFI void store_row_bf16(bf16_t* p, int lane, const float (&v)[32]) {
#pragma unroll
    for (int j = 0; j < 4; ++j) {
        u32x4 a;
#pragma unroll
        for (int q = 0; q < 4; ++q) a[q] = pk2(v[j * 8 + 2 * q], v[j * 8 + 2 * q + 1]);
        *(u32x4*)(p + j * 512 + lane * 8) = a;
    }
}
DEVFI void store_row_f32(float* p, int lane, const float (&v)[32]) {
#pragma unroll
    for (int j = 0; j < 4; ++j) {
        *(f32x4*)(p + j * 512 + lane * 8) = (f32x4){v[j * 8 + 0], v[j * 8 + 1], v[j * 8 + 2], v[j * 8 + 3]};
        *(f32x4*)(p + j * 512 + lane * 8 + 4) = (f32x4){v[j * 8 + 4], v[j * 8 + 5], v[j * 8 + 6], v[j * 8 + 7]};
    }
}

DEVFI void route16(const float (&lg)[16], const float* rb, int& e0, int& e1, float& w0, float& w1) {
    float aff[16], sel[16];
#pragma unroll
    for (int e = 0; e < 16; ++e) { aff[e] = 1.f / (1.f + __expf(-lg[e])); sel[e] = aff[e] + rb[e]; }
    float best = -3.0e38f; int gi = 0;
#pragma unroll
    for (int g = 0; g < 4; ++g) {
        const float a = sel[4 * g], b = sel[4 * g + 1], c = sel[4 * g + 2], d = sel[4 * g + 3];
        const float h1 = fmaxf(a, b), l1 = fminf(a, b), h2 = fmaxf(c, d), l2 = fminf(c, d);
        const float m1 = fmaxf(h1, h2), m2 = fmaxf(fminf(h1, h2), fmaxf(l1, l2));
        const float s = m1 + m2;
        if (s > best) { best = s; gi = g; }
    }
    float s0 = sel[0], s1 = sel[1], s2 = sel[2], s3 = sel[3], a0 = aff[0], a1 = aff[1], a2 = aff[2], a3 = aff[3];
#pragma unroll
    for (int g = 1; g < 4; ++g) if (gi == g) { s0 = sel[4 * g]; s1 = sel[4 * g + 1]; s2 = sel[4 * g + 2]; s3 = sel[4 * g + 3]; a0 = aff[4 * g]; a1 = aff[4 * g + 1]; a2 = aff[4 * g + 2]; a3 = aff[4 * g + 3]; }
    int i1 = 0; float b1 = s0;
    if (s1 > b1) { b1 = s1; i1 = 1; } if (s2 > b1) { b1 = s2; i1 = 2; } if (s3 > b1) { b1 = s3; i1 = 3; }
    int i2 = -1; float b2 = -3.0e38f;
    if (i1 != 0 && s0 > b2) { b2 = s0; i2 = 0; }
    if (i1 != 1 && s1 > b2) { b2 = s1; i2 = 1; }
    if (i1 != 2 && s2 > b2) { b2 = s2; i2 = 2; }
    if (i1 != 3 && s3 > b2) { b2 = s3; i2 = 3; }
    const float A1 = i1 == 0 ? a0 : i1 == 1 ? a1 : i1 == 2 ? a2 : a3;
    const float A2 = i2 == 0 ? a0 : i2 == 1 ? a1 : i2 == 2 ? a2 : a3;
    const float inv = 1.f / (A1 + A2);
    e0 = gi * 4 + i1; e1 = gi * 4 + i2; w0 = A1 * inv; w1 = A2 * inv;
}

DEVFI void bases_from_counts(const int* cnt, int* base  ) {
    int acc = 0;
    for (int e = 0; e < 16; ++e) { base[e] = acc; acc += ((cnt[e] + 255) >> 8) << 8; }
    base[16] = acc;
}

constexpr int RP_WL = 0, RP_CTL = 16 * 2048 * 4, RP_LDS_BYTES = RP_CTL + 4096;

DEVFI void row_pass(const RowP& P, unsigned char* lds) {
    float* Wl = (float*)(lds + RP_WL);
    int* ctl = (int*)(lds + RP_CTL);
    const int tid = threadIdx.x, lane = tid & 63, wave = tid >> 6;
    if (P.sk_kind) {
        for (int idx = tid; idx < 2048 * 4; idx += 512) {
            const int k = idx >> 2, e4 = (idx & 3) * 4;
            const f32x4 w = *(const f32x4*)(P.Wsk + (size_t)k * P.wsk_ld + e4);
            Wl[(e4 + 0) * 2048 + k] = w[0]; Wl[(e4 + 1) * 2048 + k] = w[1]; Wl[(e4 + 2) * 2048 + k] = w[2]; Wl[(e4 + 3) * 2048 + k] = w[3];
        }
    }
    if (P.mode == 2 && tid == 0) bases_from_counts(P.pCNT, ctl + 160);
    __syncthreads();
    for (int batch = blockIdx.x; batch < T / 64; batch += gridDim.x) {
        if (P.sk_kind == 2 && tid < 16) ctl[128 + tid] = 0;
        for (int it = 0; it < 8; ++it) {
            const int rl = it * 8 + wave, row = batch * 64 + rl, b = row / SEQ;
            float v[32];
            if (P.mode == 0) { load_vec32(P.xin + (size_t)row * DM, lane, v); }
            else if (P.mode == 1) { load_row_bf16(P.Z + (size_t)row * DM, lane, v); }
            else {
                float xr[32], o0[32], o1[32], g[32];
                load_row_bf16(P.XRES + (size_t)row * DM, lane, xr);
                const int e0 = P.pE01[row * 2], e1 = P.pE01[row * 2 + 1];
                const int sl0 = ctl[160 + e0] + P.pPOS[row * 2], sl1 = ctl[160 + e1] + P.pPOS[row * 2 + 1];
                load_row_bf16(P.OSLOT + (size_t)sl0 * DM, lane, o0);
                load_row_bf16(P.OSLOT + (size_t)sl1 * DM, lane, o1);
                load_vec32(P.gate + (size_t)b * 6 * DM, lane, g);
#pragma unroll
                for (int i = 0; i < 32; ++i) v[i] = ALPHA * xr[i] + (1.f + g[i]) * (o0[i] + o1[i]);
            }
            if (P.mode != 0) {
                float s = 0.f;
#pragma unroll
                for (int i = 0; i < 32; ++i) s += v[i];
                const float mean = wave_sum(s) * (1.f / DM);
                float q = 0.f;
#pragma unroll
                for (int i = 0; i < 32; ++i) { v[i] -= mean; q += v[i] * v[i]; }
                const float rstd = rsqrtf(wave_sum(q) * (1.f / DM) + LN_EPS);
                float ga[32], be[32];
                load_vec32(P.gamma, lane, ga); load_vec32(P.beta, lane, be);
#pragma unroll
                for (int i = 0; i < 32; ++i) v[i] = v[i] * rstd * ga[i] + be[i];
            }
            if (P.mode == 2 && P.last) { store_row_f32(P.OUT + (size_t)row * DM, lane, v); continue; }
            store_row_bf16(P.XRES + (size_t)row * DM, lane, v);
            {
                float sc[32], sh[32];
                load_vec32(P.sc + (size_t)b * 6 * DM, lane, sc); load_vec32(P.sh + (size_t)b * 6 * DM, lane, sh);
#pragma unroll
                for (int i = 0; i < 32; ++i) v[i] = v[i] * (1.f + sc[i]) + sh[i];
            }
            store_row_bf16(P.H + (size_t)row * DM, lane, v);
            if (P.sk_kind) {
                float lg[16];
#pragma unroll
                for (int e = 0; e < 16; ++e) {
                    float a = 0.f;
#pragma unroll
                    for (int j = 0; j < 4; ++j) {
                        const f32x4 w0 = *(const f32x4*)(Wl + e * 2048 + j * 512 + lane * 8), w1 = *(const f32x4*)(Wl + e * 2048 + j * 512 + lane * 8 + 4);
                        a += v[j * 8 + 0] * w0[0] + v[j * 8 + 1] * w0[1] + v[j * 8 + 2] * w0[2] + v[j * 8 + 3] * w0[3];
                        a += v[j * 8 + 4] * w1[0] + v[j * 8 + 5] * w1[1] + v[j * 8 + 6] * w1[2] + v[j * 8 + 7] * w1[3];
                    }
                    lg[e] = wave_sum(a);
                }
                if (P.sk_kind == 1) {
                    if (lane < 16) {
                        float xv = lg[0];
#pragma unroll
                        for (int e = 1; e < 16; ++e) if (lane == e) xv = lg[e];
                        xv += P.bsk[lane];
                        P.LOGF[(size_t)row * 16 + lane] = fminf(xv, 0.f) - log1pf(__expf(-fabsf(xv)));
                    }
                } else {
                    float rb[16];
#pragma unroll
                    for (int e = 0; e < 16; ++e) rb[e] = P.bsk[e];
                    int e0, e1; float w0, w1;
                    route16(lg, rb, e0, e1, w0, w1);
                    if (lane == 0) { P.E01[row * 2] = e0; P.E01[row * 2 + 1] = e1; P.W01[row * 2] = w0; P.W01[row * 2 + 1] = w1; ctl[rl * 2] = e0; ctl[rl * 2 + 1] = e1; }
                }
            }
        }
        if (P.sk_kind == 2) {
            __syncthreads();
            if (tid < 16) {
                int n = 0;
                for (int i = 0; i < 128; ++i) n += (ctl[i] == tid) ? 1 : 0;
                int gb = 0;
                if (n) gb = atomicAdd(P.CNT + tid, n);
                int k = 0;
                for (int i = 0; i < 128; ++i) if (ctl[i] == tid) {
                    const int tokk = (batch * 64) * 2 + i;
                    P.POS[tokk] = gb + k; P.TOK[tid * T + gb + k] = tokk; ++k;
                }
            }
            __syncthreads();
        }
    }
}
__global__ __launch_bounds__(512, 2) void k_row_pass(RowP P) {
    extern __shared__ __attribute__((aligned(16))) unsigned char lds[];
    row_pass(P, lds);
}

DEVFI void scan_bh(int bh, const float* LOGF, float* F, bf16_t* QREC, bf16_t* KREC, int lane) {
    const int b = bh >> 4, h = bh & 15;
    const float* src = LOGF + ((size_t)b * SEQ) * 16 + h;
    double s = 0.0;
    for (int i = 0; i < 128; ++i) s += (double)src[(size_t)(lane * 128 + i) * 16];
    double incl = s;
#pragma unroll
    for (int o = 1; o < 64; o <<= 1) { const double y = __shfl_up(incl, o); if (lane >= o) incl += y; }
    double run = incl - s;
    for (int i = 0; i < 128; ++i) {
        const int t = lane * 128 + i;
        run += (double)src[(size_t)t * 16];
        F[(size_t)bh * SEQ + t] = (float)run;
        const float f2 = (float)(run * 1.4426950408889634);
        const unsigned h1 = f2bf(f2); const float r1 = f2 - bf2f(h1);
        const unsigned h2 = f2bf(r1); const float r2 = r1 - bf2f(h2);
        const unsigned h3 = f2bf(r2);
        const unsigned one = 0x3F80u;
        u32x4 q, k;
        q[0] = one | (one << 16); q[1] = one | (h1 << 16); q[2] = h2 | (h3 << 16); q[3] = 0u;
        k[0] = (h1 ^ 0x8000u) | ((h2 ^ 0x8000u) << 16); k[1] = (h3 ^ 0x8000u) | (one << 16); k[2] = one | (one << 16); k[3] = 0u;
        *(u32x4*)(QREC + ((size_t)bh * SEQ + t) * 8) = q;
        *(u32x4*)(KREC + ((size_t)bh * SEQ + t) * 8) = k;
    }
}
__global__ __launch_bounds__(64) void k_scan(const float* LOGF, float* F, bf16_t* QREC, bf16_t* KREC) { scan_bh(blockIdx.x, LOGF, F, QREC, KREC, threadIdx.x); }

struct NGemm {
    const bf16_t* A; long lda; long a_goff;
    const int* arow; long arow_goff;
    const int* abase_cnt;
    const float* B; const float* B2; long ldb; long b_goff;
    const int* Mdev; int M, N, K, arow_shift;
};
template <class Epi> __global__ __launch_bounds__(256) void k_gemm_naive(NGemm g, Epi epi) {
    __shared__ float As[16][68]; __shared__ float Bs[16][68]; __shared__ float Bs2[16][68];
    const int z = blockIdx.z; const int M = g.Mdev ? g.Mdev[z] : g.M;
    const int m0 = blockIdx.y * 64, n0 = blockIdx.x * 64; if (m0 >= M) return;
    const int tid = threadIdx.x, tx = tid & 15, ty = tid >> 4;
    const int ar = tid >> 2, ak = (tid & 3) * 4;
    const int grow = m0 + ar; const bool aval = grow < M;
    long arow = 0; if (aval) arow = g.arow ? (long)(g.arow[(long)z * g.arow_goff + grow] >> g.arow_shift) : (long)grow;
    if (g.abase_cnt) { int base[17]; bases_from_counts(g.abase_cnt, base); arow += base[z]; }
    const bf16_t* Ap = g.A + (long)z * g.a_goff + arow * g.lda + ak;
    const int bk = tid >> 4, bn = (tid & 15) * 4; const bool bval = (n0 + bn) < g.N;
    const float* Bp = g.B + (long)z * g.b_goff + (long)bk * g.ldb + n0 + bn;
    const float* Bp2 = g.B2 ? g.B2 + (long)z * g.b_goff + (long)bk * g.ldb + n0 + bn : nullptr;
    float acc[4][4], acc2[4][4];
#pragma unroll
    for (int i = 0; i < 4; ++i)
#pragma unroll
        for (int j = 0; j < 4; ++j) { acc[i][j] = 0.f; acc2[i][j] = 0.f; }
    for (int k0 = 0; k0 < g.K; k0 += 16) {
        u32x2 av = (u32x2){0u, 0u}; if (aval) av = *(const u32x2*)(Ap + k0);
        f32x4 bv = (f32x4){0.f, 0.f, 0.f, 0.f}, bv2 = bv;
        if (bval) { bv = *(const f32x4*)(Bp + (long)k0 * g.ldb); if (Bp2) bv2 = *(const f32x4*)(Bp2 + (long)k0 * g.ldb); }
        As[ak + 0][ar] = bf2f(av[0] & 0xffffu); As[ak + 1][ar] = bf2f(av[0] >> 16); As[ak + 2][ar] = bf2f(av[1] & 0xffffu); As[ak + 3][ar] = bf2f(av[1] >> 16);
        *(f32x4*)&Bs[bk][bn] = bv; *(f32x4*)&Bs2[bk][bn] = bv2;
        __syncthreads();
#pragma unroll
        for (int kk = 0; kk < 16; ++kk) {
            const f32x4 a = *(const f32x4*)&As[kk][ty * 4], b = *(const f32x4*)&Bs[kk][tx * 4], b2 = *(const f32x4*)&Bs2[kk][tx * 4];
#pragma unroll
            for (int i = 0; i < 4; ++i)
#pragma unroll
                for (int j = 0; j < 4; ++j) { acc[i][j] += a[i] * b[j]; acc2[i][j] += a[i] * b2[j]; }
        }
        __syncthreads();
    }
#pragma unroll
    for (int i = 0; i < 4; ++i)
#pragma unroll
        for (int j = 0; j < 4; ++j) { const int r = m0 + ty * 4 + i, n = n0 + tx * 4 + j; if (r < M && n < g.N) epi(z, r, n, acc[i][j], acc2[i][j]); }
}
struct EpiQKVn { bf16_t* Q; bf16_t* K; bf16_t* V;
    __device__ void operator()(int, int r, int n, float a, float) const { const int w = n / DM, c = n % DM; bf16_t* o = w == 0 ? Q : (w == 1 ? K : V); o[(size_t)r * DM + c] = (bf16_t)f2bf(w == 0 ? a * QSCALE : a); } };
struct EpiResn { bf16_t* Z; const bf16_t* XRES; const float* gate; const float* cs; long gcols;
    __device__ void operator()(int z, int r, int n, float a, float) const { const int c = z * (int)gcols + n, b = r / SEQ; const float s = cs ? cs[c] : 1.f;
        Z[(size_t)r * DM + c] = (bf16_t)f2bf(ALPHA * bf2f(XRES[(size_t)r * DM + c]) + (1.f + gate[(size_t)b * 6 * DM + c]) * s * a); } };
struct EpiGUn { bf16_t* HID; const int* CNT; const int* TOK; const float* W01;
    __device__ void operator()(int z, int r, int n, float a, float u) const { int base[17]; bases_from_counts(CNT, base); const int slot = base[z] + r; const float w = W01[TOK[(size_t)z * T + r]];
        HID[(size_t)slot * DE + n] = (bf16_t)f2bf(silu_f(a) * u * w); } };
struct EpiDownn { bf16_t* OS; const int* CNT;
    __device__ void operator()(int z, int r, int n, float a, float) const { int base[17]; bases_from_counts(CNT, base); OS[(size_t)(base[z] + r) * DM + n] = (bf16_t)f2bf(a); } };

__global__ __launch_bounds__(256) void k_attn_naive(const bf16_t* Q, const bf16_t* K, const bf16_t* V, const float* F, bf16_t* O) {
    extern __shared__ __attribute__((aligned(16))) unsigned char lds[];
    float* Qs = (float*)lds;
    float* Ks = Qs + 64 * 129;
    float* Vs = Ks + 64 * 129;
    float* Ss = Vs + 64 * 128;
    float* ms = Ss + 64 * 65; float* ls = ms + 64; float* al = ls + 64; float* Fq = al + 64; float* Fk = Fq + 64;
    const int qb = 127 - blockIdx.x, bh = blockIdx.y, b = bh >> 4, h = bh & 15, tid = threadIdx.x;
    const size_t rowbase = (size_t)b * SEQ; const int q0 = qb * 64;
    for (int idx = tid; idx < 64 * 16; idx += 256) { const int r = idx >> 4, c8 = (idx & 15) * 8;
        const u32x4 a = *(const u32x4*)(Q + (rowbase + q0 + r) * DM + h * HD + c8);
#pragma unroll
        for (int q = 0; q < 4; ++q) { Qs[r * 129 + c8 + 2 * q] = bf2f(a[q] & 0xffffu); Qs[r * 129 + c8 + 2 * q + 1] = bf2f(a[q] >> 16); } }
    if (tid < 64) { ms[tid] = -1e30f; ls[tid] = 0.f; Fq[tid] = F[(size_t)bh * SEQ + q0 + tid] * LOG2E; }
    float o[32];
#pragma unroll
    for (int c = 0; c < 32; ++c) o[c] = 0.f;
    const int tx = tid & 15, ty = tid >> 4, pr = tid >> 2, pc0 = (tid & 3) * 32;
    for (int kt = 0; kt <= qb; ++kt) {
        __syncthreads();
        const int k0 = kt * 64;
        for (int idx = tid; idx < 64 * 16; idx += 256) { const int r = idx >> 4, c8 = (idx & 15) * 8;
            const u32x4 a = *(const u32x4*)(K + (rowbase + k0 + r) * DM + h * HD + c8), vv = *(const u32x4*)(V + (rowbase + k0 + r) * DM + h * HD + c8);
#pragma unroll
            for (int q = 0; q < 4; ++q) { Ks[r * 129 + c8 + 2 * q] = bf2f(a[q] & 0xffffu); Ks[r * 129 + c8 + 2 * q + 1] = bf2f(a[q] >> 16);
                Vs[r * 128 + c8 + 2 * q] = bf2f(vv[q] & 0xffffu); Vs[r * 128 + c8 + 2 * q + 1] = bf2f(vv[q] >> 16); } }
        if (tid < 64) Fk[tid] = F[(size_t)bh * SEQ + k0 + tid] * LOG2E;
        __syncthreads();
        float s[4][4];
#pragma unroll
        for (int i = 0; i < 4; ++i)
#pragma unroll
            for (int j = 0; j < 4; ++j) s[i][j] = 0.f;
        for (int d = 0; d < 128; ++d) {
            float a[4], bb[4];
#pragma unroll
            for (int i = 0; i < 4; ++i) { a[i] = Qs[(ty * 4 + i) * 129 + d]; bb[i] = Ks[(tx * 4 + i) * 129 + d]; }
#pragma unroll
            for (int i = 0; i < 4; ++i)
#pragma unroll
                for (int j = 0; j < 4; ++j) s[i][j] += a[i] * bb[j];
        }
#pragma unroll
        for (int i = 0; i < 4; ++i)
#pragma unroll
            for (int j = 0; j < 4; ++j) { const int r = ty * 4 + i, c = tx * 4 + j; float x = s[i][j] + Fq[r] - Fk[c]; if (k0 + c > q0 + r) x = -__builtin_inff(); Ss[r * 65 + c] = x; }
        __syncthreads();
        if (tid < 64) { const int r = tid; float m = ms[r];  float mx = m;
            for (int c = 0; c < 64; ++c) mx = fmaxf(mx, Ss[r * 65 + c]);
            const float a = exp2f(m - mx); float sum = 0.f;
            for (int c = 0; c < 64; ++c) { const float p = exp2f(Ss[r * 65 + c] - mx); Ss[r * 65 + c] = p; sum += p; }
            ms[r] = mx; ls[r] = ls[r] * a + sum; al[r] = a; }
        __syncthreads();
        { const float a = al[pr];
#pragma unroll
          for (int c = 0; c < 32; ++c) o[c] *= a;
          for (int j = 0; j < 64; ++j) { const float p = Ss[pr * 65 + j];
#pragma unroll
              for (int c4 = 0; c4 < 8; ++c4) { const f32x4 vv = *(const f32x4*)(Vs + j * 128 + pc0 + c4 * 4); o[c4 * 4 + 0] += p * vv[0]; o[c4 * 4 + 1] += p * vv[1]; o[c4 * 4 + 2] += p * vv[2]; o[c4 * 4 + 3] += p * vv[3]; } } }
    }
    __syncthreads();
    { const float inv = 1.f / ls[pr]; bf16_t* op = O + (rowbase + q0 + pr) * DM + h * HD + pc0;
#pragma unroll
      for (int c8 = 0; c8 < 4; ++c8) { u32x4 w;
#pragma unroll
          for (int q = 0; q < 4; ++q) w[q] = pk2(o[c8 * 8 + 2 * q] * inv, o[c8 * 8 + 2 * q + 1] * inv);
          *(u32x4*)(op + c8 * 8) = w; } }
}

__global__ __launch_bounds__(256) void k_pool_d(const bf16_t* H, bf16_t* D) {
    const int idx = blockIdx.x * 256 + threadIdx.x;
    const int row = idx >> 8, c8 = (idx & 255) * 8, t = row % SEQ, g = c8 / PGC, w = 2 << g;
    const int nw = t + 1 < w ? t + 1 : w;
    float s[8];
#pragma unroll
    for (int i = 0; i < 8; ++i) s[i] = 0.f;
    float cur[8];
    for (int d = 0; d < nw; ++d) {
        const u32x4 a = *(const u32x4*)(H + (size_t)(row - d) * DM + c8);
#pragma unroll
        for (int q = 0; q < 4; ++q) { const float lo = bf2f(a[q] & 0xffffu), hi = bf2f(a[q] >> 16); s[2 * q] += lo; s[2 * q + 1] += hi; if (d == 0) { cur[2 * q] = lo; cur[2 * q + 1] = hi; } }
    }
    const float inv = 1.f / (float)nw; u32x4 o;
#pragma unroll
    for (int q = 0; q < 4; ++q) o[q] = pk2(s[2 * q] * inv - cur[2 * q], s[2 * q + 1] * inv - cur[2 * q + 1]);
    *(u32x4*)(D + (size_t)row * DM + c8) = o;
}

extern "C" void kernel_launch(void* const* d_in, const int* in_sizes, int n_in, void* d_out, int out_size, void* d_ws, size_t ws_size, hipStream_t stream) {
    static bool init = false;
    if (!init) { init = true;
        if (ws_size < WS_END) fprintf(stderr, "kernel_launch: workspace too small: %zu < %zu\n", ws_size, (size_t)WS_END);
        (void)hipFuncSetAttribute((const void*)k_row_pass, hipFuncAttributeMaxDynamicSharedMemorySize, RP_LDS_BYTES);
        (void)hipFuncSetAttribute((const void*)k_attn_naive, hipFuncAttributeMaxDynamicSharedMemorySize, 120 * 1024);
    }
    const float* x = (const float*)d_in[0]; const float* c = (const float*)d_in[1]; const float* ada_w = (const float*)d_in[2]; const float* ada_b = (const float*)d_in[3];
    const float* fox_w_in = (const float*)d_in[4]; const float* fox_b_f = (const float*)d_in[5]; const float* fox_w_o = (const float*)d_in[6];
    const float* pool_w = (const float*)d_in[7]; const float* pool_scale = (const float*)d_in[8]; const float* router_w = (const float*)d_in[9]; const float* router_b = (const float*)d_in[10];
    const float* w_gate = (const float*)d_in[11]; const float* w_up = (const float*)d_in[12]; const float* w_down = (const float*)d_in[13];
    const float* ln_g = (const float*)d_in[14]; const float* ln_b = (const float*)d_in[15];
    unsigned char* ws = (unsigned char*)d_ws;
    int* ctl = (int*)(ws + WS_CTL); float* mods = (float*)(ws + WS_MODS); float* LOGF = (float*)(ws + WS_LOGF); float* F = (float*)(ws + WS_F);
    bf16_t* QREC = (bf16_t*)(ws + WS_QREC); bf16_t* KREC = (bf16_t*)(ws + WS_KREC);
    int* E01 = (int*)(ws + WS_E01); float* W01 = (float*)(ws + WS_W01); int* POS = (int*)(ws + WS_POS); int* TOK = (int*)(ws + WS_TOK);
    bf16_t* XRES = (bf16_t*)(ws + WS_XRES); bf16_t* H = (bf16_t*)(ws + WS_H); bf16_t* Qb = (bf16_t*)(ws + WS_Q); bf16_t* Kb = (bf16_t*)(ws + WS_K); bf16_t* Vb = (bf16_t*)(ws + WS_V);
    bf16_t* Ob = (bf16_t*)(ws + WS_O); bf16_t* Z = (bf16_t*)(ws + WS_Z); bf16_t* HID = (bf16_t*)(ws + WS_HID); bf16_t* OSLOT = (bf16_t*)(ws + WS_OSLOT);
    float* out = (float*)d_out;

    (void)hipMemsetAsync(ws + WS_CTL, 0, CTL_BYTES, stream);
    k_ada_naive<<<DEPTH * 6 * DM / 256, 256, 0, stream>>>(c, ada_w, ada_b, mods);
    auto MOD = [&](int i, int chunk) { return mods + (size_t)i * 2 * 6 * DM + (size_t)chunk * DM; };

    for (int i = 0; i < DEPTH; ++i) {
        const int j = i / 2; const bool fox = (i % 2) == 0;
        RowP P; memset(&P, 0, sizeof(P));
        if (i == 0) {
            P.mode = 0; P.xin = x; P.XRES = XRES; P.H = H; P.sh = MOD(0, 0); P.sc = MOD(0, 1);
            P.sk_kind = 1; P.Wsk = fox_w_in + 3 * DM; P.wsk_ld = DIN; P.bsk = fox_b_f; P.LOGF = LOGF;
            k_row_pass<<<256, 512, RP_LDS_BYTES, stream>>>(P);
        }
        if (fox) {
            k_scan<<<32, 64, 0, stream>>>(LOGF, F, QREC, KREC);
            { NGemm g; memset(&g, 0, sizeof(g)); g.A = H; g.lda = DM; g.B = fox_w_in + (size_t)j * DM * DIN; g.ldb = DIN; g.M = T; g.N = 3 * DM; g.K = DM;
              k_gemm_naive<EpiQKVn><<<dim3(3 * DM / 64, T / 64, 1), 256, 0, stream>>>(g, EpiQKVn{Qb, Kb, Vb}); }
            k_attn_naive<<<dim3(128, 32), 256, 120 * 1024, stream>>>(Qb, Kb, Vb, F, Ob);
            { NGemm g; memset(&g, 0, sizeof(g)); g.A = Ob; g.lda = DM; g.B = fox_w_o + (size_t)j * DM * DM; g.ldb = DM; g.M = T; g.N = DM; g.K = DM;
              k_gemm_naive<EpiResn><<<dim3(DM / 64, T / 64, 1), 256, 0, stream>>>(g, EpiResn{Z, XRES, MOD(i, 2), nullptr, 0L}); }
        } else {
            k_pool_d<<<T * 256 / 256, 256, 0, stream>>>(H, Qb);
            { NGemm g; memset(&g, 0, sizeof(g)); g.A = Qb; g.lda = DM; g.a_goff = PGC; g.B = pool_w + (size_t)j * NPG * PGC * PGC; g.ldb = PGC; g.b_goff = (long)PGC * PGC; g.M = T; g.N = PGC; g.K = PGC;
              k_gemm_naive<EpiResn><<<dim3(PGC / 64, T / 64, NPG), 256, 0, stream>>>(g, EpiResn{Z, XRES, MOD(i, 2), pool_scale + (size_t)j * DM, (long)PGC}); }
        }
        int* CNT = ctl + CW_CNT + i * 64;
        {
            memset(&P, 0, sizeof(P)); P.mode = 1; P.Z = Z; P.XRES = XRES; P.H = H; P.gamma = ln_g + (size_t)(i * 2 + 0) * DM; P.beta = ln_b + (size_t)(i * 2 + 0) * DM;
            P.sh = MOD(i, 3); P.sc = MOD(i, 4); P.sk_kind = 2; P.Wsk = router_w; P.wsk_ld = NE; P.bsk = router_b;
            P.E01 = E01; P.W01 = W01; P.POS = POS; P.CNT = CNT; P.TOK = TOK;
            k_row_pass<<<256, 512, RP_LDS_BYTES, stream>>>(P);
        }
        {
            NGemm g; memset(&g, 0, sizeof(g)); g.A = H; g.lda = DM; g.arow = TOK; g.arow_goff = T; g.arow_shift = 1;
            g.B = w_gate + (size_t)i * NE * DM * DE; g.B2 = w_up + (size_t)i * NE * DM * DE; g.ldb = DE; g.b_goff = (long)DM * DE; g.Mdev = CNT; g.N = DE; g.K = DM;
            k_gemm_naive<EpiGUn><<<dim3(DE / 64, T / 64, NE), 256, 0, stream>>>(g, EpiGUn{HID, CNT, TOK, W01});
        }
        {
            NGemm g; memset(&g, 0, sizeof(g)); g.A = HID; g.lda = DE; g.abase_cnt = CNT;
            g.B = w_down + (size_t)i * NE * DE * DM; g.ldb = DM; g.b_goff = (long)DE * DM; g.Mdev = CNT; g.N = DM; g.K = DE;
            k_gemm_naive<EpiDownn><<<dim3(DM / 64, T / 64, NE), 256, 0, stream>>>(g, EpiDownn{OSLOT, CNT});
        }
        {
            memset(&P, 0, sizeof(P)); P.mode = 2; P.last = (i == DEPTH - 1) ? 1 : 0; P.XRES = XRES; P.H = H; P.OUT = out; P.OSLOT = OSLOT;
            P.gamma = ln_g + (size_t)(i * 2 + 1) * DM; P.beta = ln_b + (size_t)(i * 2 + 1) * DM; P.gate = MOD(i, 5);
            P.pE01 = E01; P.pPOS = POS; P.pCNT = CNT;
            if (i + 1 < DEPTH) { P.sh = MOD(i + 1, 0); P.sc = MOD(i + 1, 1);
                if ((i + 1) % 2 == 0) { const int jn = (i + 1) / 2; P.sk_kind = 1; P.Wsk = fox_w_in + (size_t)jn * DM * DIN + 3 * DM; P.wsk_ld = DIN; P.bsk = fox_b_f + (size_t)jn * NH; P.LOGF = LOGF; } }
            k_row_pass<<<256, 512, RP_LDS_BYTES, stream>>>(P);
        }
    }
    (void)n_in; (void)in_sizes; (void)out_size;
}
```

```cpp
#include <hip/hip_runtime.h>
#include <cstdint>
#include <cstdio>
#include <cstring>

#define DEVFI __device__ __forceinline__
typedef unsigned short bf16_t;
typedef float f32x4 __attribute__((ext_vector_type(4)));
typedef unsigned u32x4 __attribute__((ext_vector_type(4)));
typedef unsigned u32x2 __attribute__((ext_vector_type(2)));

constexpr int DM = 2048, NB = 2, SEQ = 8192, T = NB * SEQ, DEPTH = 4, NH = 16, HD = 128, NE = 16, DE = 512;
constexpr int NPG = 4, PGC = 512;
constexpr int DIN = 3 * DM + NH;
constexpr float ALPHA = 1.681792830507429f;
constexpr float LN_EPS = 1e-5f;
constexpr float LOG2E = 1.4426950408889634f;
constexpr float QSCALE = 0.08838834764831845f * 1.4426950408889634f;
constexpr int SLOT_ROWS = 2 * T + NE * 256;

constexpr size_t MiB = 1u << 20;
constexpr size_t WS_CTL   = 0;
constexpr size_t CTL_BYTES = 1 * MiB;
constexpr size_t WS_MODS  = 1 * MiB;
constexpr size_t WS_LOGF  = 2 * MiB;
constexpr size_t WS_F     = 3 * MiB;
constexpr size_t WS_QREC  = 4 * MiB;
constexpr size_t WS_KREC  = 8 * MiB;
constexpr size_t WS_E01   = 12 * MiB;
constexpr size_t WS_W01   = 13 * MiB;
constexpr size_t WS_POS   = 14 * MiB;
constexpr size_t WS_TOK   = 15 * MiB;
constexpr size_t WS_XRES  = 16 * MiB;
constexpr size_t WS_H     = 80 * MiB;
constexpr size_t WS_Q     = 144 * MiB;
constexpr size_t WS_K     = 208 * MiB;
constexpr size_t WS_V     = 272 * MiB;
constexpr size_t WS_O     = 336 * MiB;
constexpr size_t WS_Z     = 400 * MiB;
constexpr size_t WS_HID   = 464 * MiB;
constexpr size_t WS_OSLOT = 512 * MiB;
constexpr size_t WS_WIN_T = 672 * MiB;
constexpr size_t WS_WO_T  = 720 * MiB;
constexpr size_t WS_POOL_T = 736 * MiB;
constexpr size_t WS_W13_T = 744 * MiB;
constexpr size_t WS_WD_T  = 1000 * MiB;
constexpr size_t WS_END   = 1128 * MiB;
constexpr int CW_CNT = 1024;
constexpr int CW_BAR = 4096;

DEVFI float bf2f(unsigned b) { return __uint_as_float(b << 16); }
DEVFI unsigned f2bf(float f) { unsigned u = __float_as_uint(f); return (u + 0x7fffu + ((u >> 16) & 1u)) >> 16; }
DEVFI unsigned pk2(float lo, float hi) { return f2bf(lo) | (f2bf(hi) << 16); }
DEVFI float wave_sum(float v) {
#pragma unroll
    for (int o = 1; o < 64; o <<= 1) v += __shfl_xor(v, o);
    return v;
}
DEVFI float silu_f(float a) { return a / (1.f + __expf(-a)); }

__global__ __launch_bounds__(256) void k_ada_naive(const float* __restrict__ c, const float* __restrict__ ada_w, const float* __restrict__ ada_b, float* __restrict__ mods) {
    const int idx = blockIdx.x * 256 + threadIdx.x;
    const int i = idx / (6 * DM), n = idx % (6 * DM);
    const float* w = ada_w + (size_t)i * DM * 6 * DM + n;
    float a0 = 0.f, a1 = 0.f;
    for (int k = 0; k < DM; ++k) {
        const float wv = w[(size_t)k * 6 * DM];
        a0 += silu_f(c[k]) * wv; a1 += silu_f(c[DM + k]) * wv;
    }
    const float bv = ada_b[(size_t)i * 6 * DM + n];
    mods[((size_t)i * 2 + 0) * 6 * DM + n] = a0 + bv;
    mods[((size_t)i * 2 + 1) * 6 * DM + n] = a1 + bv;
}

struct RowP {
    int mode;
    int last;
    int sk_kind;
    int wsk_ld;
    const float* xin; const bf16_t* Z; bf16_t* XRES; bf16_t* H; float* OUT; const bf16_t* OSLOT;
    const float* gamma; const float* beta;
    const float* sh; const float* sc;
    const float* gate;
    const float* Wsk; const float* bsk;
    float* LOGF; int* E01; float* W01; int* POS; int* CNT; int* TOK;
    const int* pE01; const int* pPOS; const int* pCNT;
};

DEVFI void load_vec32(const float* p, int lane, float (&v)[32]) {
#pragma unroll
    for (int j = 0; j < 4; ++j) {
        const f32x4 a = *(const f32x4*)(p + j * 512 + lane * 8), b = *(const f32x4*)(p + j * 512 + lane * 8 + 4);
        v[j * 8 + 0] = a[0]; v[j * 8 + 1] = a[1]; v[j * 8 + 2] = a[2]; v[j * 8 + 3] = a[3];
        v[j * 8 + 4] = b[0]; v[j * 8 + 5] = b[1]; v[j * 8 + 6] = b[2]; v[j * 8 + 7] = b[3];
    }
}
DEVFI void load_row_bf16(const bf16_t* p, int lane, float (&v)[32]) {
#pragma unroll
    for (int j = 0; j < 4; ++j) {
        const u32x4 a = *(const u32x4*)(p + j * 512 + lane * 8);
#pragma unroll
        for (int q = 0; q < 4; ++q) { v[j * 8 + 2 * q] = bf2f(a[q] & 0xffffu); v[j * 8 + 2 * q + 1] = bf2f(a[q] >> 16); }
    }
}
DEVFI void store_row_bf16(bf16_t* p, int lane, const float (&v)[32]) {
#pragma unroll
    for (int j = 0; j < 4; ++j) {
        u32x4 a;
#pragma unroll
        for (int q = 0; q < 4; ++q) a[q] = pk2(v[j * 8 + 2 * q], v[j * 8 + 2 * q + 1]);
        *(u32x4*)(p + j * 512 + lane * 8) = a;
    }
}
DEVFI void store_row_f32(float* p, int lane, const float (&v)[32]) {
#pragma unroll
    for (int j = 0; j < 4; ++j) {
        *(f32x4*)(p + j * 512 + lane * 8) = (f32x4){v[j * 8 + 0], v[j * 8 + 1], v[j * 8 + 2], v[j * 8 + 3]};
        *(f32x4*)(p + j * 512 + lane * 8 + 4) = (f32x4){v[j * 8 + 4], v[j * 8 + 5], v[j * 8 + 6], v[j * 8 + 7]};
    }
}

DEVFI void route16(const float (&lg)[16], const float* rb, int& e0, int& e1, float& w0, float& w1) {
    float aff[16], sel[16];
#pragma unroll
    for (int e = 0; e < 16; ++e) { aff[e] = 1.f / (1.f + __expf(-lg[e])); sel[e] = aff[e] + rb[e]; }
    float best = -3.0e38f; int gi = 0;
#pragma unroll
    for (int g = 0; g < 4; ++g) {
        const float a = sel[4 * g], b = sel[4 * g + 1], c = sel[4 * g + 2], d = sel[4 * g + 3];
        const float h1 = fmaxf(a, b), l1 = fminf(a, b), h2 = fmaxf(c, d), l2 = fminf(c, d);
        const float m1 = fmaxf(h1, h2), m2 = fmaxf(fminf(h1, h2), fmaxf(l1, l2));
        const float s = m1 + m2;
        if (s > best) { best = s; gi = g; }
    }
    float s0 = sel[0], s1 = sel[1], s2 = sel[2], s3 = sel[3], a0 = aff[0], a1 = aff[1], a2 = aff[2], a3 = aff[3];
#pragma unroll
    for (int g = 1; g < 4; ++g) if (gi == g) { s0 = sel[4 * g]; s1 = sel[4 * g + 1]; s2 = sel[4 * g + 2]; s3 = sel[4 * g + 3]; a0 = aff[4 * g]; a1 = aff[4 * g + 1]; a2 = aff[4 * g + 2]; a3 = aff[4 * g + 3]; }
    int i1 = 0; float b1 = s0;
    if (s1 > b1) { b1 = s1; i1 = 1; } if (s2 > b1) { b1 = s2; i1 = 2; } if (s3 > b1) { b1 = s3; i1 = 3; }
    int i2 = -1; float b2 = -3.0e38f;
    if (i1 != 0 && s0 > b2) { b2 = s0; i2 = 0; }
    if (i1 != 1 && s1 > b2) { b2 = s1; i2 = 1; }
    if (i1 != 2 && s2 > b2) { b2 = s2; i2 = 2; }
    if (i1 != 3 && s3 > b2) { b2 = s3; i2 = 3; }
    const float A1 = i1 == 0 ? a0 : i1 == 1 ? a1 : i1 == 2 ? a2 : a3;
    const float A2 = i2 == 0 ? a0 : i2 == 1 ? a1 : i2 == 2 ? a2 : a3;
    const float inv = 1.f / (A1 + A2);
    e0 = gi * 4 + i1; e1 = gi * 4 + i2; w0 = A1 * inv; w1 = A2 * inv;
}

DEVFI void bases_from_counts(const int* cnt, int* base  ) {
    int acc = 0;
    for (int e = 0; e < 16; ++e) { base[e] = acc; acc += ((cnt[e] + 255) >> 8) << 8; }
    base[16] = acc;
}

constexpr int RP_WL = 0, RP_CTL = 16 * 2048 * 4, RP_LDS_BYTES = RP_CTL + 4096;

DEVFI void unpack8(const u32x4 a, float (&o)[8]) {
#pragma unroll
    for (int q = 0; q < 4; ++q) { o[2 * q] = bf2f(a[q] & 0xffffu); o[2 * q + 1] = bf2f(a[q] >> 16); }
}
DEVFI void load8f(const float* p, float (&o)[8]) {
    const f32x4 a = *(const f32x4*)p, b = *(const f32x4*)(p + 4);
    o[0] = a[0]; o[1] = a[1]; o[2] = a[2]; o[3] = a[3]; o[4] = b[0]; o[5] = b[1]; o[6] = b[2]; o[7] = b[3];
}
template <int MODE>
DEVFI void row_pass(const int tid, const RowP& P, unsigned char* lds) {
    float* Wl = (float*)(lds + RP_WL);
    int* ctl = (int*)(lds + RP_CTL);
    const int lane0 = tid & 63, wave = tid >> 6;
    if (P.sk_kind) {
        for (int idx = tid; idx < 2048 * 4; idx += 512) {
            const int k = idx >> 2, e4 = (idx & 3) * 4;
            const f32x4 w = *(const f32x4*)(P.Wsk + (size_t)k * P.wsk_ld + e4);
            Wl[(e4 + 0) * 2048 + k] = w[0]; Wl[(e4 + 1) * 2048 + k] = w[1]; Wl[(e4 + 2) * 2048 + k] = w[2]; Wl[(e4 + 3) * 2048 + k] = w[3];
        }
    }
    if (MODE == 2 && tid == 0) bases_from_counts(P.pCNT, ctl + 160);
    __syncthreads();
    for (int batch = blockIdx.x; batch < T / 64; batch += gridDim.x) {
        for (int it = 0; it < 8; ++it) {
            int lane = lane0; asm volatile("" : "+v"(lane));
            const int rl = it * 8 + wave, row = batch * 64 + rl, b = row / SEQ;
            const int cb = lane * 8;
            float v[32];
            if (MODE == 0) {
#pragma unroll
                for (int j = 0; j < 4; ++j) { float t8[8]; load8f(P.xin + (size_t)row * DM + j * 512 + cb, t8);
#pragma unroll
                    for (int i = 0; i < 8; ++i) v[j * 8 + i] = t8[i]; }
            } else if (MODE == 1) {
#pragma unroll
                for (int j = 0; j < 4; ++j) { float t8[8]; unpack8(*(const u32x4*)(P.Z + (size_t)row * DM + j * 512 + cb), t8);
#pragma unroll
                    for (int i = 0; i < 8; ++i) v[j * 8 + i] = t8[i]; }
            } else {
                const int e0 = P.pE01[row * 2], e1 = P.pE01[row * 2 + 1];
                const int sl0 = ctl[160 + e0] + P.pPOS[row * 2], sl1 = ctl[160 + e1] + P.pPOS[row * 2 + 1];
#pragma unroll
                for (int j = 0; j < 4; ++j) { float xr[8], o0[8], o1[8], g[8];
                    unpack8(*(const u32x4*)(P.XRES + (size_t)row * DM + j * 512 + cb), xr);
                    unpack8(*(const u32x4*)(P.OSLOT + (size_t)sl0 * DM + j * 512 + cb), o0);
                    unpack8(*(const u32x4*)(P.OSLOT + (size_t)sl1 * DM + j * 512 + cb), o1);
                    load8f(P.gate + (size_t)b * 6 * DM + j * 512 + cb, g);
#pragma unroll
                    for (int i = 0; i < 8; ++i) v[j * 8 + i] = ALPHA * xr[i] + (1.f + g[i]) * (o0[i] + o1[i]); }
            }
            if (MODE != 0) {
                float s = 0.f;
#pragma unroll
                for (int i = 0; i < 32; ++i) s += v[i];
                const float mean = wave_sum(s) * (1.f / DM);
                float q = 0.f;
#pragma unroll
                for (int i = 0; i < 32; ++i) { v[i] -= mean; q += v[i] * v[i]; }
                const float rstd = rsqrtf(wave_sum(q) * (1.f / DM) + LN_EPS);
#pragma unroll
                for (int j = 0; j < 4; ++j) { float ga[8], be[8]; load8f(P.gamma + j * 512 + cb, ga); load8f(P.beta + j * 512 + cb, be);
#pragma unroll
                    for (int i = 0; i < 8; ++i) v[j * 8 + i] = v[j * 8 + i] * rstd * ga[i] + be[i]; }
            }
            if (MODE == 2 && P.last) {
#pragma unroll
                for (int j = 0; j < 4; ++j) { float* op = P.OUT + (size_t)row * DM + j * 512 + cb;
                    *(f32x4*)op = (f32x4){v[j * 8 + 0], v[j * 8 + 1], v[j * 8 + 2], v[j * 8 + 3]}; *(f32x4*)(op + 4) = (f32x4){v[j * 8 + 4], v[j * 8 + 5], v[j * 8 + 6], v[j * 8 + 7]}; }
                continue;
            }
#pragma unroll
            for (int j = 0; j < 4; ++j) {
                u32x4 a;
#pragma unroll
                for (int q = 0; q < 4; ++q) a[q] = pk2(v[j * 8 + 2 * q], v[j * 8 + 2 * q + 1]);
                *(u32x4*)(P.XRES + (size_t)row * DM + j * 512 + cb) = a;
                float sc[8], sh[8]; load8f(P.sc + (size_t)b * 6 * DM + j * 512 + cb, sc); load8f(P.sh + (size_t)b * 6 * DM + j * 512 + cb, sh);
#pragma unroll
                for (int i = 0; i < 8; ++i) v[j * 8 + i] = v[j * 8 + i] * (1.f + sc[i]) + sh[i];
#pragma unroll
                for (int q = 0; q < 4; ++q) a[q] = pk2(v[j * 8 + 2 * q], v[j * 8 + 2 * q + 1]);
                *(u32x4*)(P.H + (size_t)row * DM + j * 512 + cb) = a;
            }
            if (P.sk_kind) {
                float lg[16];
#pragma unroll
                for (int e = 0; e < 16; ++e) {
                    float a = 0.f;
#pragma unroll
                    for (int j = 0; j < 4; ++j) {
                        const f32x4 w0 = *(const f32x4*)(Wl + e * 2048 + j * 512 + cb), w1 = *(const f32x4*)(Wl + e * 2048 + j * 512 + cb + 4);
                        a += v[j * 8 + 0] * w0[0] + v[j * 8 + 1] * w0[1] + v[j * 8 + 2] * w0[2] + v[j * 8 + 3] * w0[3];
                        a += v[j * 8 + 4] * w1[0] + v[j * 8 + 5] * w1[1] + v[j * 8 + 6] * w1[2] + v[j * 8 + 7] * w1[3];
                    }
                    lg[e] = wave_sum(a);
                }
                if (MODE != 1) {
                    if (lane < 16) {
                        float xv = lg[0];
#pragma unroll
                        for (int e = 1; e < 16; ++e) if (lane == e) xv = lg[e];
                        xv += P.bsk[lane];
                        P.LOGF[(size_t)row * 16 + lane] = fminf(xv, 0.f) - log1pf(__expf(-fabsf(xv)));
                    }
                } else {
                    float rb[16];
#pragma unroll
                    for (int e = 0; e < 16; ++e) rb[e] = P.bsk[e];
                    int e0, e1; float w0, w1;
                    route16(lg, rb, e0, e1, w0, w1);
                    if (lane == 0) { P.E01[row * 2] = e0; P.E01[row * 2 + 1] = e1; P.W01[row * 2] = w0; P.W01[row * 2 + 1] = w1; ctl[rl * 2] = e0; ctl[rl * 2 + 1] = e1; }
                }
            }
        }
        if (MODE == 1) {
            __syncthreads();
            if (tid < 16) {
                int n = 0;
                for (int i = 0; i < 128; ++i) n += (ctl[i] == tid) ? 1 : 0;
                int gb = 0;
                if (n) gb = atomicAdd(P.CNT + tid, n);
                int k = 0;
                for (int i = 0; i < 128; ++i) if (ctl[i] == tid) {
                    const int tokk = (batch * 64) * 2 + i;
                    P.POS[tokk] = gb + k; P.TOK[tid * T + gb + k] = tokk; ++k;
                }
            }
            __syncthreads();
        }
    }
}

struct NGemm {
    const bf16_t* A; long lda; long a_goff;
    const int* arow; long arow_goff;
    const int* abase_cnt;
    const float* B; const float* B2; long ldb; long b_goff;
    const int* Mdev; int M, N, K, arow_shift;
};
template <class Epi> __global__ __launch_bounds__(256) void k_gemm_naive(NGemm g, Epi epi) {
    __shared__ float As[16][68]; __shared__ float Bs[16][68]; __shared__ float Bs2[16][68];
    const int z = blockIdx.z; const int M = g.Mdev ? g.Mdev[z] : g.M;
    const int m0 = blockIdx.y * 64, n0 = blockIdx.x * 64; if (m0 >= M) return;
    const int tid = threadIdx.x, tx = tid & 15, ty = tid >> 4;
    const int ar = tid >> 2, ak = (tid & 3) * 4;
    const int grow = m0 + ar; const bool aval = grow < M;
    long arow = 0; if (aval) arow = g.arow ? (long)(g.arow[(long)z * g.arow_goff + grow] >> g.arow_shift) : (long)grow;
    if (g.abase_cnt) { int base[17]; bases_from_counts(g.abase_cnt, base); arow += base[z]; }
    const bf16_t* Ap = g.A + (long)z * g.a_goff + arow * g.lda + ak;
    const int bk = tid >> 4, bn = (tid & 15) * 4; const bool bval = (n0 + bn) < g.N;
    const float* Bp = g.B + (long)z * g.b_goff + (long)bk * g.ldb + n0 + bn;
    const float* Bp2 = g.B2 ? g.B2 + (long)z * g.b_goff + (long)bk * g.ldb + n0 + bn : nullptr;
    float acc[4][4], acc2[4][4];
#pragma unroll
    for (int i = 0; i < 4; ++i)
#pragma unroll
        for (int j = 0; j < 4; ++j) { acc[i][j] = 0.f; acc2[i][j] = 0.f; }
    for (int k0 = 0; k0 < g.K; k0 += 16) {
        u32x2 av = (u32x2){0u, 0u}; if (aval) av = *(const u32x2*)(Ap + k0);
        f32x4 bv = (f32x4){0.f, 0.f, 0.f, 0.f}, bv2 = bv;
        if (bval) { bv = *(const f32x4*)(Bp + (long)k0 * g.ldb); if (Bp2) bv2 = *(const f32x4*)(Bp2 + (long)k0 * g.ldb); }
        As[ak + 0][ar] = bf2f(av[0] & 0xffffu); As[ak + 1][ar] = bf2f(av[0] >> 16); As[ak + 2][ar] = bf2f(av[1] & 0xffffu); As[ak + 3][ar] = bf2f(av[1] >> 16);
        *(f32x4*)&Bs[bk][bn] = bv; *(f32x4*)&Bs2[bk][bn] = bv2;
        __syncthreads();
#pragma unroll
        for (int kk = 0; kk < 16; ++kk) {
            const f32x4 a = *(const f32x4*)&As[kk][ty * 4], b = *(const f32x4*)&Bs[kk][tx * 4], b2 = *(const f32x4*)&Bs2[kk][tx * 4];
#pragma unroll
            for (int i = 0; i < 4; ++i)
#pragma unroll
                for (int j = 0; j < 4; ++j) { acc[i][j] += a[i] * b[j]; acc2[i][j] += a[i] * b2[j]; }
        }
        __syncthreads();
    }
#pragma unroll
    for (int i = 0; i < 4; ++i)
#pragma unroll
        for (int j = 0; j < 4; ++j) { const int r = m0 + ty * 4 + i, n = n0 + tx * 4 + j; if (r < M && n < g.N) epi(z, r, n, acc[i][j], acc2[i][j]); }
}
struct EpiQKVn { bf16_t* Q; bf16_t* K; bf16_t* V;
    __device__ void operator()(int, int r, int n, float a, float) const { const int w = n / DM, c = n % DM; bf16_t* o = w == 0 ? Q : (w == 1 ? K : V); o[(size_t)r * DM + c] = (bf16_t)f2bf(w == 0 ? a * QSCALE : a); } };
struct EpiResn { bf16_t* Z; const bf16_t* XRES; const float* gate; const float* cs; long gcols;
    __device__ void operator()(int z, int r, int n, float a, float) const { const int c = z * (int)gcols + n, b = r / SEQ; const float s = cs ? cs[c] : 1.f;
        Z[(size_t)r * DM + c] = (bf16_t)f2bf(ALPHA * bf2f(XRES[(size_t)r * DM + c]) + (1.f + gate[(size_t)b * 6 * DM + c]) * s * a); } };
struct EpiGUn { bf16_t* HID; const int* CNT; const int* TOK; const float* W01;
    __device__ void operator()(int z, int r, int n, float a, float u) const { int base[17]; bases_from_counts(CNT, base); const int slot = base[z] + r; const float w = W01[TOK[(size_t)z * T + r]];
        HID[(size_t)slot * DE + n] = (bf16_t)f2bf(silu_f(a) * u * w); } };
struct EpiDownn { bf16_t* OS; const int* CNT;
    __device__ void operator()(int z, int r, int n, float a, float) const { int base[17]; bases_from_counts(CNT, base); OS[(size_t)(base[z] + r) * DM + n] = (bf16_t)f2bf(a); } };

__global__ __launch_bounds__(256) void k_attn_naive(const bf16_t* Q, const bf16_t* K, const bf16_t* V, const float* F, bf16_t* O) {
    extern __shared__ __attribute__((aligned(16))) unsigned char lds[];
    float* Qs = (float*)lds;
    float* Ks = Qs + 64 * 129;
    float* Vs = Ks + 64 * 129;
    float* Ss = Vs + 64 * 128;
    float* ms = Ss + 64 * 65; float* ls = ms + 64; float* al = ls + 64; float* Fq = al + 64; float* Fk = Fq + 64;
    const int qb = 127 - blockIdx.x, bh = blockIdx.y, b = bh >> 4, h = bh & 15, tid = threadIdx.x;
    const size_t rowbase = (size_t)b * SEQ; const int q0 = qb * 64;
    for (int idx = tid; idx < 64 * 16; idx += 256) { const int r = idx >> 4, c8 = (idx & 15) * 8;
        const u32x4 a = *(const u32x4*)(Q + (rowbase + q0 + r) * DM + h * HD + c8);
#pragma unroll
        for (int q = 0; q < 4; ++q) { Qs[r * 129 + c8 + 2 * q] = bf2f(a[q] & 0xffffu); Qs[r * 129 + c8 + 2 * q + 1] = bf2f(a[q] >> 16); } }
    if (tid < 64) { ms[tid] = -1e30f; ls[tid] = 0.f; Fq[tid] = F[(size_t)bh * SEQ + q0 + tid] * LOG2E; }
    float o[32];
#pragma unroll
    for (int c = 0; c < 32; ++c) o[c] = 0.f;
    const int tx = tid & 15, ty = tid >> 4, pr = tid >> 2, pc0 = (tid & 3) * 32;
    for (int kt = 0; kt <= qb; ++kt) {
        __syncthreads();
        const int k0 = kt * 64;
        for (int idx = tid; idx < 64 * 16; idx += 256) { const int r = idx >> 4, c8 = (idx & 15) * 8;
            const u32x4 a = *(const u32x4*)(K + (rowbase + k0 + r) * DM + h * HD + c8), vv = *(const u32x4*)(V + (rowbase + k0 + r) * DM + h * HD + c8);
#pragma unroll
            for (int q = 0; q < 4; ++q) { Ks[r * 129 + c8 + 2 * q] = bf2f(a[q] & 0xffffu); Ks[r * 129 + c8 + 2 * q + 1] = bf2f(a[q] >> 16);
                Vs[r * 128 + c8 + 2 * q] = bf2f(vv[q] & 0xffffu); Vs[r * 128 + c8 + 2 * q + 1] = bf2f(vv[q] >> 16); } }
        if (tid < 64) Fk[tid] = F[(size_t)bh * SEQ + k0 + tid] * LOG2E;
        __syncthreads();
        float s[4][4];
#pragma unroll
        for (int i = 0; i < 4; ++i)
#pragma unroll
            for (int j = 0; j < 4; ++j) s[i][j] = 0.f;
        for (int d = 0; d < 128; ++d) {
            float a[4], bb[4];
#pragma unroll
            for (int i = 0; i < 4; ++i) { a[i] = Qs[(ty * 4 + i) * 129 + d]; bb[i] = Ks[(tx * 4 + i) * 129 + d]; }
#pragma unroll
            for (int i = 0; i < 4; ++i)
#pragma unroll
                for (int j = 0; j < 4; ++j) s[i][j] += a[i] * bb[j];
        }
#pragma unroll
        for (int i = 0; i < 4; ++i)
#pragma unroll
            for (int j = 0; j < 4; ++j) { const int r = ty * 4 + i, c = tx * 4 + j; float x = s[i][j] + Fq[r] - Fk[c]; if (k0 + c > q0 + r) x = -__builtin_inff(); Ss[r * 65 + c] = x; }
        __syncthreads();
        if (tid < 64) { const int r = tid; float m = ms[r];  float mx = m;
            for (int c = 0; c < 64; ++c) mx = fmaxf(mx, Ss[r * 65 + c]);
            const float a = exp2f(m - mx); float sum = 0.f;
            for (int c = 0; c < 64; ++c) { const float p = exp2f(Ss[r * 65 + c] - mx); Ss[r * 65 + c] = p; sum += p; }
            ms[r] = mx; ls[r] = ls[r] * a + sum; al[r] = a; }
        __syncthreads();
        { const float a = al[pr];
#pragma unroll
          for (int c = 0; c < 32; ++c) o[c] *= a;
          for (int j = 0; j < 64; ++j) { const float p = Ss[pr * 65 + j];
#pragma unroll
              for (int c4 = 0; c4 < 8; ++c4) { const f32x4 vv = *(const f32x4*)(Vs + j * 128 + pc0 + c4 * 4); o[c4 * 4 + 0] += p * vv[0]; o[c4 * 4 + 1] += p * vv[1]; o[c4 * 4 + 2] += p * vv[2]; o[c4 * 4 + 3] += p * vv[3]; } } }
    }
    __syncthreads();
    { const float inv = 1.f / ls[pr]; bf16_t* op = O + (rowbase + q0 + pr) * DM + h * HD + pc0;
#pragma unroll
      for (int c8 = 0; c8 < 4; ++c8) { u32x4 w;
#pragma unroll
          for (int q = 0; q < 4; ++q) w[q] = pk2(o[c8 * 8 + 2 * q] * inv, o[c8 * 8 + 2 * q + 1] * inv);
          *(u32x4*)(op + c8 * 8) = w; } }
}

__global__ __launch_bounds__(256) void k_pool_d(const bf16_t* H, bf16_t* D) {
    const int idx = blockIdx.x * 256 + threadIdx.x;
    const int row = idx >> 8, c8 = (idx & 255) * 8, t = row % SEQ, g = c8 / PGC, w = 2 << g;
    const int nw = t + 1 < w ? t + 1 : w;
    float s[8];
#pragma unroll
    for (int i = 0; i < 8; ++i) s[i] = 0.f;
    float cur[8];
    for (int d = 0; d < nw; ++d) {
        const u32x4 a = *(const u32x4*)(H + (size_t)(row - d) * DM + c8);
#pragma unroll
        for (int q = 0; q < 4; ++q) { const float lo = bf2f(a[q] & 0xffffu), hi = bf2f(a[q] >> 16); s[2 * q] += lo; s[2 * q + 1] += hi; if (d == 0) { cur[2 * q] = lo; cur[2 * q + 1] = hi; } }
    }
    const float inv = 1.f / (float)nw; u32x4 o;
#pragma unroll
    for (int q = 0; q < 4; ++q) o[q] = pk2(s[2 * q] * inv - cur[2 * q], s[2 * q + 1] * inv - cur[2 * q + 1]);
    *(u32x4*)(D + (size_t)row * DM + c8) = o;
}


namespace pg8 {
#define PG8_LAS __attribute__((address_space(3)))
typedef short bf16x8 __attribute__((ext_vector_type(8)));
constexpr int BM = 256, BK = 64, HALF = 128, HTB = HALF * BK * 2, STAGE_BYTES = 8 * HTB, NXCD = 8, WGM = 8;
__host__ __device__ __forceinline__ int lds_byte(int r, int c) { const int st = (r >> 4) * 2 + (c >> 5), rr = r & 15, cc = c & 31, ob = rr * 64 + cc * 2; return st * 1024 + (ob ^ (((ob >> 9) & 1) << 5)); }
__host__ __device__ __forceinline__ void stage_rc(int b, int& R, int& C) { const int st = b / 1024, sb = b % 1024, swz = sb ^ (((sb >> 9) & 1) << 5); R = (st >> 1) * 16 + swz / 64; C = (st & 1) * 32 + (swz % 64) / 2; }
__host__ __device__ __forceinline__ int perm32(int rho) { const int n = rho >> 4, i = rho & 15; return 8 * (i >> 2) + 4 * n + (i & 3); }

struct Unit {
    int crow0, ccol0;
    int e;
    int arow0, acol0;
    int nvalid;
    long boff;
};

struct StaticOrder {
    static constexpr bool GATHER = false;
    int nM, nN, nwg, G, c, mode, lda, ldb;
    __device__ __forceinline__ void init(int nM_, int nN_, int G_, int c_, int mode_, int lda_, int ldb_) { nM = nM_; nN = nN_; nwg = nM * nN; G = G_; c = c_; mode = mode_; lda = lda_; ldb = ldb_; }
    __device__ __forceinline__ bool next(int i, Unit& u) const {
        const long L = (long)i * G + c; if (L >= nwg) return false;
        int wgid = (int)L; { const int q = nwg / NXCD, r = nwg % NXCD, xcd = wgid % NXCD, off = wgid / NXCD; wgid = (xcd < r ? xcd * (q + 1) : r * (q + 1) + (xcd - r) * q) + off; }
        const int nig = WGM * nN, gid = wgid / nig, fm = gid * WGM, gsz = (nM - fm) < WGM ? (nM - fm) : WGM;
        const int pm = fm + ((wgid % nig) % gsz), pn = (wgid % nig) / gsz;
        u.crow0 = pm * BM; u.ccol0 = pn * BM; u.arow0 = pm * BM; u.nvalid = 256;
        if (mode == 0) { u.e = 0; u.acol0 = 0; u.boff = (long)pn * BM * ldb; }
        else { u.e = pn >> 1; u.acol0 = (pn >> 1) * 512; u.boff = (long)pn * BM * ldb; }
        return true;
    }
    __device__ __forceinline__ unsigned a_off(const Unit& u, int h, int R, int C) const { return (unsigned)(((u.arow0 + h * HALF + R) * lda + u.acol0 + C) * 2); }
    __device__ __forceinline__ long a_base(const Unit& u) const { return (long)u.arow0 * lda + u.acol0; }
    __device__ __forceinline__ int a_ld() const { return lda; }
};
struct MoeOrder {
    static constexpr bool GATHER = true;
    const int* tp;
    const int* cnt;
    const int* TOK;
    int npn, G, c, m1, lda;
    __device__ __forceinline__ bool next(int i, Unit& u) const {
        const long L = (long)i * G + c; const int total = __builtin_amdgcn_readfirstlane(tp[16]) * npn; if (L >= total) return false;
        const int rtg = (int)L / npn, pn = (int)L % npn; int e = 0;
#pragma unroll
        for (int k = 1; k < 16; ++k) e += (rtg >= __builtin_amdgcn_readfirstlane(tp[k])) ? 1 : 0;
        const int rt = rtg - __builtin_amdgcn_readfirstlane(tp[e]); int nv = __builtin_amdgcn_readfirstlane(cnt[e]) - rt * 256; nv = nv > 256 ? 256 : nv;
        u.e = e; u.nvalid = nv; u.crow0 = rtg * 256; u.acol0 = 0;
        if (m1) { u.arow0 = rt * 256; u.ccol0 = pn * 128; u.boff = ((long)e * 1024 + pn * 256) * 2048; }
        else    { u.arow0 = rtg * 256; u.ccol0 = pn * 256; u.boff = ((long)e * 2048 + pn * 256) * 512; }
        return true;
    }
    __device__ __forceinline__ unsigned a_off(const Unit& u, int h, int R, int C) const {
        const int rl = h * HALF + R;
        if (m1) { int row = 0; if (rl < u.nvalid) row = TOK[(size_t)u.e * T + u.arow0 + rl] >> 1; return (unsigned)((row * lda + C) * 2); }
        return (unsigned)(((u.arow0 + rl) * lda + C) * 2);
    }
    __device__ __forceinline__ long a_base(const Unit&) const { return 0; }
    __device__ __forceinline__ int a_ld() const { return lda; }
};

__device__ __forceinline__ unsigned cvt_pk_bf16(float lo, float hi) { unsigned r; asm volatile("v_cvt_pk_bf16_f32 %0, %1, %2" : "=v"(r) : "v"(lo), "v"(hi)); return r; }

struct EpiQKV {
    bf16_t* Q; long stride;
    __device__ __forceinline__ void operator()(const f32x4 (&acc)[2][2][4][2], const Unit& u, int wr, int wc, int fr, int fq) const {
        const int t = u.ccol0 / DM; bf16_t* base = Q + (size_t)t * stride; const float sc = t == 0 ? QSCALE : 1.f;
        const int col0 = u.ccol0 - t * DM + wc * 32 + 8 * fq, row0 = u.crow0 + wr * 64 + fr;
#pragma unroll
        for (int ai = 0; ai < 2; ++ai)
#pragma unroll
            for (int m = 0; m < 4; ++m) { bf16_t* rowp = base + (size_t)(row0 + ai * HALF + m * 16) * DM + col0;
#pragma unroll
                for (int bj = 0; bj < 2; ++bj) { const f32x4 v0 = acc[ai][bj][m][0] * sc, v1 = acc[ai][bj][m][1] * sc;
                    u32x4 w; w.x = cvt_pk_bf16(v0[0], v0[1]); w.y = cvt_pk_bf16(v0[2], v0[3]); w.z = cvt_pk_bf16(v1[0], v1[1]); w.w = cvt_pk_bf16(v1[2], v1[3]);
                    *(u32x4*)(rowp + bj * HALF) = w; } }
    }
};
struct EpiRes {
    bf16_t* Z; const bf16_t* XRES; const float* gate; const float* cs;
    __device__ __forceinline__ void operator()(const f32x4 (&acc)[2][2][4][2], const Unit& u, int wr, int wc, int fr, int fq) const {
        const int b = u.crow0 / SEQ, col0 = u.ccol0 + wc * 32 + 8 * fq, row0 = u.crow0 + wr * 64 + fr;
        f32x4 mu[2][2];
#pragma unroll
        for (int bj = 0; bj < 2; ++bj)
#pragma unroll
            for (int n = 0; n < 2; ++n) { const f32x4 g = *(const f32x4*)(gate + (size_t)b * 6 * DM + col0 + bj * HALF + 4 * n);
                f32x4 s = (f32x4){1.f, 1.f, 1.f, 1.f}; if (cs) s = *(const f32x4*)(cs + col0 + bj * HALF + 4 * n);
                mu[bj][n] = (g + 1.f) * s; }
#pragma unroll
        for (int ai = 0; ai < 2; ++ai)
#pragma unroll
            for (int m = 0; m < 4; ++m) { const size_t ro = (size_t)(row0 + ai * HALF + m * 16) * DM + col0;
#pragma unroll
                for (int bj = 0; bj < 2; ++bj) { const u32x4 xr = *(const u32x4*)(XRES + ro + bj * HALF);
                    f32x4 x0, x1; x0[0] = bf2f(xr.x & 0xffffu); x0[1] = bf2f(xr.x >> 16); x0[2] = bf2f(xr.y & 0xffffu); x0[3] = bf2f(xr.y >> 16);
                    x1[0] = bf2f(xr.z & 0xffffu); x1[1] = bf2f(xr.z >> 16); x1[2] = bf2f(xr.w & 0xffffu); x1[3] = bf2f(xr.w >> 16);
                    const f32x4 v0 = x0 * ALPHA + mu[bj][0] * acc[ai][bj][m][0], v1 = x1 * ALPHA + mu[bj][1] * acc[ai][bj][m][1];
                    u32x4 w; w.x = cvt_pk_bf16(v0[0], v0[1]); w.y = cvt_pk_bf16(v0[2], v0[3]); w.z = cvt_pk_bf16(v1[0], v1[1]); w.w = cvt_pk_bf16(v1[2], v1[3]);
                    *(u32x4*)(Z + ro + bj * HALF) = w; } }
    }
};
__device__ __forceinline__ float silu_fast(float a) { return a * __builtin_amdgcn_rcpf(1.f + __builtin_amdgcn_exp2f(-a * LOG2E)); }
struct EpiGU {
    bf16_t* HID; const int* TOK; const float* W01;
    __device__ __forceinline__ void operator()(const f32x4 (&acc)[2][2][4][2], const Unit& u, int wr, int wc, int fr, int fq) const {
        const int col0 = u.ccol0 + wc * 32 + 8 * fq;
#pragma unroll
        for (int ai = 0; ai < 2; ++ai)
#pragma unroll
            for (int m = 0; m < 4; ++m) { const int rl = ai * HALF + wr * 64 + m * 16 + fr; float w = 0.f;
                if (rl < u.nvalid) w = W01[TOK[(size_t)u.e * T + u.arow0 + rl]];
                const f32x4 a0 = acc[ai][0][m][0], a1 = acc[ai][0][m][1], u0 = acc[ai][1][m][0], u1 = acc[ai][1][m][1];
                f32x4 h0, h1;
#pragma unroll
                for (int q = 0; q < 4; ++q) { h0[q] = silu_fast(a0[q]) * u0[q] * w; h1[q] = silu_fast(a1[q]) * u1[q] * w; }
                u32x4 o; o.x = cvt_pk_bf16(h0[0], h0[1]); o.y = cvt_pk_bf16(h0[2], h0[3]); o.z = cvt_pk_bf16(h1[0], h1[1]); o.w = cvt_pk_bf16(h1[2], h1[3]);
                *(u32x4*)(HID + (size_t)(u.crow0 + rl) * DE + col0) = o; }
    }
};
struct EpiDown {
    bf16_t* OS;
    __device__ __forceinline__ void operator()(const f32x4 (&acc)[2][2][4][2], const Unit& u, int wr, int wc, int fr, int fq) const {
        const int col0 = u.ccol0 + wc * 32 + 8 * fq, row0 = u.crow0 + wr * 64 + fr;
#pragma unroll
        for (int ai = 0; ai < 2; ++ai)
#pragma unroll
            for (int m = 0; m < 4; ++m) { bf16_t* rowp = OS + (size_t)(row0 + ai * HALF + m * 16) * DM + col0;
#pragma unroll
                for (int bj = 0; bj < 2; ++bj) { const f32x4 v0 = acc[ai][bj][m][0], v1 = acc[ai][bj][m][1];
                    u32x4 w; w.x = cvt_pk_bf16(v0[0], v0[1]); w.y = cvt_pk_bf16(v0[2], v0[3]); w.z = cvt_pk_bf16(v1[0], v1[1]); w.w = cvt_pk_bf16(v1[2], v1[3]);
                    *(u32x4*)(rowp + bj * HALF) = w; } }
    }
};

template <class Epi, class Sched, bool ALIGN_EPI>
__device__ __forceinline__ void gemm_phase(const int tid, PG8_LAS unsigned char* lds, const bf16_t* A, const bf16_t* Bt, const int ldb, const int K, const Sched& S, const Epi& E) {
    const int wid = __builtin_amdgcn_readfirstlane(tid >> 6), lane = tid & 63, wr = wid >> 2, wc = wid & 3, fr = lane & 15, fq = lane >> 4;
    const int nt = K / BK;
    unsigned voffB[2]; int RA[2], CA[2];
#pragma unroll
    for (int i = 0; i < 2; ++i) { int R, C; stage_rc(tid * 16 + i * 8192, R, C); const int Rb = (R & ~31) + perm32(R & 31);
        RA[i] = R; CA[i] = C; voffB[i] = (unsigned)(Rb * ldb + C) * 2u; }
    const size_t kstep = (size_t)(BK * 2);
    const size_t hstepB = (size_t)HALF * ldb * 2;
    const unsigned ldsw = (unsigned)wid * 1024u;
    const int aoff = lds_byte(wr * 64 + fr, fq * 8), boff = lds_byte(wc * 32 + fr, fq * 8);
#define PG8_SA(b, h) (((b) * 2 + (h)) * HTB)
#define PG8_SB(b, h) ((4 + (b) * 2 + (h)) * HTB)
#define PG8_STAGE(bufoff, gbase, voff) do { _Pragma("unroll") for (int _i = 0; _i < 2; ++_i) \
        __builtin_amdgcn_global_load_lds((const unsigned*)((const char*)(gbase) + (voff)[_i]), (PG8_LAS unsigned*)(lds + (bufoff) + ldsw + _i * 8192), 16, 0, 0); } while (0)
#define PG8_LDA(dst, b, h) do { _Pragma("unroll") for (int m = 0; m < 4; ++m) _Pragma("unroll") for (int k = 0; k < 2; ++k) dst[m][k] = *(const PG8_LAS bf16x8*)(lds + PG8_SA(b, h) + aoff + m * 2048 + k * 1024); } while (0)
#define PG8_LDB(dst, b, h) do { _Pragma("unroll") for (int n = 0; n < 2; ++n) _Pragma("unroll") for (int k = 0; k < 2; ++k) dst[n][k] = *(const PG8_LAS bf16x8*)(lds + PG8_SB(b, h) + boff + n * 2048 + k * 1024); } while (0)
#define PG8_MMA(ai, bj, At, Bt_) do { __builtin_amdgcn_s_setprio(1); _Pragma("unroll") for (int m = 0; m < 4; ++m) _Pragma("unroll") for (int n = 0; n < 2; ++n) _Pragma("unroll") for (int k = 0; k < 2; ++k) \
        acc[ai][bj][m][n] = __builtin_amdgcn_mfma_f32_16x16x32_bf16(Bt_[n][k], At[m][k], acc[ai][bj][m][n], 0, 0, 0); __builtin_amdgcn_s_setprio(0); } while (0)
#define PG8_WAIT_V(n) asm volatile("s_waitcnt vmcnt(" #n ")" ::: "memory")
#define PG8_WAIT_L(n) asm volatile("s_waitcnt lgkmcnt(" #n ")" ::: "memory")
#define PG8_BAR __builtin_amdgcn_s_barrier()
#define PG8_SCHED __builtin_amdgcn_sched_barrier(0)
    Unit cur, nxt; int ui = 0;
    if (!S.next(0, cur)) return;
    f32x4 acc[2][2][4][2];
#pragma unroll
    for (int a = 0; a < 2; ++a)
#pragma unroll
        for (int b = 0; b < 2; ++b)
#pragma unroll
            for (int m = 0; m < 4; ++m)
#pragma unroll
                for (int n = 0; n < 2; ++n) acc[a][b][m][n] = (f32x4){0.f, 0.f, 0.f, 0.f};
    bf16x8 At[4][2], B0[2][2], B1[2][2];
    constexpr bool GA = Sched::GATHER;
    unsigned vA0[2], vA1[2], nA0[2], nA1[2];
    const int lda = S.a_ld();
    if constexpr (GA) {
#pragma unroll
        for (int i = 0; i < 2; ++i) { vA0[i] = S.a_off(cur, 0, RA[i], CA[i]); vA1[i] = S.a_off(cur, 1, RA[i], CA[i]); nA0[i] = vA0[i]; nA1[i] = vA1[i]; }
    } else {
#pragma unroll
        for (int i = 0; i < 2; ++i) { vA0[i] = (unsigned)(RA[i] * lda + CA[i]) * 2u; vA1[i] = vA0[i]; nA0[i] = vA0[i]; nA1[i] = vA0[i]; }
    }
    const size_t hstepA = GA ? (size_t)0 : (size_t)HALF * lda * 2;
    const char* cA = (const char*)(A + S.a_base(cur));
    const char* cB = (const char*)(Bt + cur.boff);
    PG8_STAGE(PG8_SB(0, 0), cB, voffB); PG8_STAGE(PG8_SB(0, 1), cB + hstepB, voffB); PG8_STAGE(PG8_SA(0, 0), cA, vA0); PG8_STAGE(PG8_SA(0, 1), cA + hstepA, vA1);
    if (wr == 1) PG8_BAR;
    PG8_WAIT_V(2); PG8_BAR;
    PG8_STAGE(PG8_SB(1, 0), cB + kstep, voffB); PG8_STAGE(PG8_SA(1, 0), cA + kstep, vA0); PG8_STAGE(PG8_SB(1, 1), cB + hstepB + kstep, voffB);
    PG8_WAIT_V(6); PG8_BAR;
    for (;;) {
        const bool has_next = S.next(ui + 1, nxt);
        if constexpr (GA) {
            if (has_next) {
#pragma unroll
                for (int i = 0; i < 2; ++i) { nA0[i] = S.a_off(nxt, 0, RA[i], CA[i]); nA1[i] = S.a_off(nxt, 1, RA[i], CA[i]); }
            } else {
#pragma unroll
                for (int i = 0; i < 2; ++i) { nA0[i] = vA0[i]; nA1[i] = vA1[i]; }
            }
        }
        const char* nA = has_next ? (const char*)(A + S.a_base(nxt)) : cA;
        const char* nB = has_next ? (const char*)(Bt + nxt.boff) : cB;
        for (int t = 0; t < nt; t += 2) {
            const bool last = (t == nt - 2);
            const char* a1 = cA + (size_t)(t + 1) * kstep;
            const char* a2 = last ? nA : cA + (size_t)(t + 2) * kstep; const char* b2 = last ? nB : cB + (size_t)(t + 2) * kstep;
            const char* a3 = a2 + kstep; const char* b3 = b2 + kstep;
            unsigned s0[2], s1[2];
#pragma unroll
            for (int i = 0; i < 2; ++i) { if constexpr (GA) { s0[i] = last ? nA0[i] : vA0[i]; s1[i] = last ? nA1[i] : vA1[i]; } else { s0[i] = vA0[i]; s1[i] = vA0[i]; } }
            PG8_LDB(B0, 0, 0); PG8_LDB(B1, 0, 1); PG8_SCHED; PG8_LDA(At, 0, 0); PG8_STAGE(PG8_SA(1, 1), a1 + hstepA, vA1);
            PG8_WAIT_V(8); PG8_WAIT_L(0); PG8_BAR; PG8_MMA(0, 0, At, B0); PG8_MMA(0, 1, At, B1); PG8_BAR; PG8_SCHED;
            PG8_LDA(At, 0, 1); PG8_STAGE(PG8_SB(0, 0), b2, voffB); PG8_STAGE(PG8_SB(0, 1), b2 + hstepB, voffB); PG8_STAGE(PG8_SA(0, 0), a2, s0);
            PG8_WAIT_V(8); PG8_WAIT_L(0); PG8_BAR; PG8_MMA(1, 0, At, B0); PG8_MMA(1, 1, At, B1); PG8_BAR; PG8_SCHED;
            PG8_LDB(B0, 1, 0); PG8_LDB(B1, 1, 1); PG8_SCHED; PG8_LDA(At, 1, 0); PG8_STAGE(PG8_SA(0, 1), a2 + hstepA, s1);
            PG8_WAIT_V(8); PG8_WAIT_L(0); PG8_BAR; PG8_MMA(0, 0, At, B0); PG8_MMA(0, 1, At, B1); PG8_BAR; PG8_SCHED;
            PG8_LDA(At, 1, 1); PG8_STAGE(PG8_SB(1, 0), b3, voffB); PG8_STAGE(PG8_SB(1, 1), b3 + hstepB, voffB); PG8_STAGE(PG8_SA(1, 0), a3, s0);
            PG8_WAIT_V(8); PG8_WAIT_L(0); PG8_BAR; PG8_MMA(1, 0, At, B0); PG8_MMA(1, 1, At, B1); PG8_BAR; PG8_SCHED;
        }
        if constexpr (ALIGN_EPI) { if (wr == 0) PG8_BAR; }
        E(acc, cur, wr, wc, fr, fq);
        if (!has_next) break;
#pragma unroll
        for (int a = 0; a < 2; ++a)
#pragma unroll
            for (int b = 0; b < 2; ++b)
#pragma unroll
                for (int m = 0; m < 4; ++m)
#pragma unroll
                    for (int n = 0; n < 2; ++n) acc[a][b][m][n] = (f32x4){0.f, 0.f, 0.f, 0.f};
        cur = nxt; cB = nB; cA = nA; ++ui;
        if constexpr (GA) {
#pragma unroll
            for (int i = 0; i < 2; ++i) { vA0[i] = nA0[i]; vA1[i] = nA1[i]; } }
        if constexpr (ALIGN_EPI) { if (wr == 1) PG8_BAR; }
    }
    PG8_WAIT_V(0);
    if constexpr (!ALIGN_EPI) { if (wr == 0) PG8_BAR; }
    PG8_BAR;
#undef PG8_SA
#undef PG8_SB
#undef PG8_STAGE
#undef PG8_LDA
#undef PG8_LDB
#undef PG8_MMA
#undef PG8_WAIT_V
#undef PG8_WAIT_L
#undef PG8_BAR
#undef PG8_SCHED
}
}

namespace fox {
typedef short bf16x8 __attribute__((ext_vector_type(8)));
typedef short s16x4 __attribute__((ext_vector_type(4)));
typedef float f32x16 __attribute__((ext_vector_type(16)));
constexpr int NW = 8, QBLK = 32, KVBLK = 64, QB = NW * QBLK, D = 128, LD = 2048;
constexpr int SHM_V = KVBLK * D * 2, SHM_K = KVBLK * D * 2, SHM_KX = KVBLK * 4;
constexpr int OFF_K = 2 * SHM_V, OFF_KX = OFF_K + 2 * SHM_K, OFF_WS = OFF_KX + 2 * SHM_KX;
constexpr int LDS_BYTES = OFF_WS + NW * 64 * 4;
constexpr float THR = 8.f;
#define KSWZ(row, colB) ((row) * 256 + ((colB) ^ (((row) & 7) << 4)))
#define SBAR() __builtin_amdgcn_sched_barrier(0)
__device__ __forceinline__ int v_st(int k, int c) { const int kk = (k & ~0xC) | ((k & 4) << 1) | ((k & 8) >> 1); return ((kk >> 3) * 4 + (c >> 5)) * 512 + ((kk & 7) * 32 + (c & 31)) * 2; }
__device__ __forceinline__ int v_rd_base(int lane) { return ((lane & 3) << 3) | (((lane >> 2) & 3) << 6) | (((lane >> 4) & 1) << 5) | (((lane >> 5) & 1) << 8); }
constexpr int v_rd_off(int d0, int ks, int half) { return d0 * 512 + ks * 4096 + half * 2048; }
__device__ __forceinline__ int crow(int r, int hi) { return (r & 3) + 8 * (r >> 2) + 4 * hi; }
__device__ __forceinline__ unsigned cvtpk(float lo, float hi) { unsigned r; asm volatile("v_cvt_pk_bf16_f32 %0, %1, %2" : "=v"(r) : "v"(lo), "v"(hi)); return r; }
__device__ __forceinline__ bf16x8 load8(const bf16_t* p) { return *reinterpret_cast<const bf16x8*>(p); }
__device__ __forceinline__ void mask_tile(f32x16& p0, f32x16& p1, int dq) {
    const float NEG = -__builtin_inff();
#pragma unroll
    for (int r = 0; r < 16; ++r) {
        const int c = (r & 3) + 8 * (r >> 2);
        if (dq - c < 0) p0[r] = NEG;
        if (dq - c - 32 < 0) p1[r] = NEG;
    }
}
__device__ __forceinline__ void partialSM(f32x16& p0, f32x16& p1, float& m_reg, float& mn, float& alpha) {
    float pmax = p0[0]; for (int r = 1; r < 16; ++r) pmax = fmaxf(pmax, p0[r]); for (int r = 0; r < 16; ++r) pmax = fmaxf(pmax, p1[r]);
    { auto rr = __builtin_amdgcn_permlane32_swap(__float_as_uint(pmax), __float_as_uint(pmax), false, false);
      pmax = fmaxf(__uint_as_float(rr[0]), __uint_as_float(rr[1])); }
    if (__builtin_expect(__all((pmax - m_reg) <= THR), 1)) { mn = m_reg; alpha = 1.f; }
    else { mn = fmaxf(m_reg, pmax); alpha = __builtin_amdgcn_exp2f(m_reg - mn); m_reg = mn; }
    for (int r = 0; r < 16; ++r) p0[r] = p0[r] - mn; for (int r = 0; r < 16; ++r) p1[r] = p1[r] - mn;
    for (int r = 0; r < 16; ++r) p0[r] = __builtin_amdgcn_exp2f(p0[r]);
}
__device__ __forceinline__ void finishSM(f32x16& p0, f32x16& p1, float alpha, float& l_reg, bf16x8& pa0, bf16x8& pa1, bf16x8& pa2, bf16x8& pa3) {
    for (int r = 0; r < 16; ++r) p1[r] = __builtin_amdgcn_exp2f(p1[r]);
    float ps = 0; for (int r = 0; r < 16; ++r) ps += p0[r]; for (int r = 0; r < 16; ++r) ps += p1[r];
    { auto rr = __builtin_amdgcn_permlane32_swap(__float_as_uint(ps), __float_as_uint(ps), false, false);
      ps = __uint_as_float(rr[0]) + __uint_as_float(rr[1]); }
    l_reg = l_reg * alpha + ps;
#define PK4(P, B_, OUT) do { unsigned a0 = cvtpk(P[B_+0], P[B_+1]), a1 = cvtpk(P[B_+2], P[B_+3]);                          \
        unsigned b0 = cvtpk(P[B_+4], P[B_+5]), b1 = cvtpk(P[B_+6], P[B_+7]);                                             \
        auto r0 = __builtin_amdgcn_permlane32_swap(a0, b0, false, false); auto r1 = __builtin_amdgcn_permlane32_swap(a1, b1, false, false); \
        u32x4 w = {r0[0], r1[0], r0[1], r1[1]}; OUT = *reinterpret_cast<bf16x8*>(&w); } while (0)
    PK4(p0, 0, pa0); PK4(p0, 8, pa1); PK4(p1, 0, pa2); PK4(p1, 8, pa3);
#undef PK4
}
template <int KB>
__device__ __forceinline__ void qkt(f32x16& p0, f32x16& p1, const char* lds, int r32, int hi, const bf16x8* qr) {
    {
        const float* kx = (const float*)(lds + OFF_KX + KB * SHM_KX) + 4 * hi;
#pragma unroll
        for (int g = 0; g < 4; ++g) { const f32x4 a = *(const f32x4*)(kx + 8 * g), b = *(const f32x4*)(kx + 32 + 8 * g);
            p0[4 * g] = a[0]; p0[4 * g + 1] = a[1]; p0[4 * g + 2] = a[2]; p0[4 * g + 3] = a[3];
            p1[4 * g] = b[0]; p1[4 * g + 1] = b[1]; p1[4 * g + 2] = b[2]; p1[4 * g + 3] = b[3]; }
    }
    const char* K_lds = lds + OFF_K;
    const char* kb[4];
#pragma unroll
    for (int dd = 0; dd < 4; ++dd) kb[dd] = K_lds + KB * SHM_K + KSWZ(r32, (dd * 16 + hi * 8) * 2);
#pragma unroll
    for (int d0 = 0; d0 < 8; ++d0) { const char* a = kb[d0 & 3] + (d0 >> 2) * 128;
        bf16x8 b0 = *reinterpret_cast<const bf16x8*>(a);
        bf16x8 b1 = *reinterpret_cast<const bf16x8*>(a + 32 * 256);
        p0 = __builtin_amdgcn_mfma_f32_32x32x16_bf16(b0, qr[d0], p0, 0, 0, 0);
        p1 = __builtin_amdgcn_mfma_f32_32x32x16_bf16(b1, qr[d0], p1, 0, 0, 0); }
}
template <int VB>
__device__ __forceinline__ void pv_tile(f32x16* o, int vb0, bf16x8 pa0, bf16x8 pa1, bf16x8 pa2, bf16x8 pa3) {
#define TRRD(dst, off) asm volatile("ds_read_b64_tr_b16 %0, %1 offset:%2" : "=&v"(dst) : "v"(vb0), "i"(off) : "memory")
#define PV_D0(d0) do { s16x4 l0, l1, l2, l3, h0, h1, h2, h3; constexpr int b_ = VB * SHM_V + v_rd_off(d0, 0, 0); \
        TRRD(l0, b_); TRRD(h0, b_ + 2048); TRRD(l1, b_ + 4096); TRRD(h1, b_ + 6144); TRRD(l2, b_ + 8192); TRRD(h2, b_ + 10240); TRRD(l3, b_ + 12288); TRRD(h3, b_ + 14336); \
        asm volatile("s_waitcnt lgkmcnt(0)" ::: "memory"); SBAR();   \
        o[d0] = __builtin_amdgcn_mfma_f32_32x32x16_bf16(pa0, (bf16x8){l0[0], l0[1], l0[2], l0[3], h0[0], h0[1], h0[2], h0[3]}, o[d0], 0, 0, 0);   \
        o[d0] = __builtin_amdgcn_mfma_f32_32x32x16_bf16(pa1, (bf16x8){l1[0], l1[1], l1[2], l1[3], h1[0], h1[1], h1[2], h1[3]}, o[d0], 0, 0, 0);   \
        o[d0] = __builtin_amdgcn_mfma_f32_32x32x16_bf16(pa2, (bf16x8){l2[0], l2[1], l2[2], l2[3], h2[0], h2[1], h2[2], h2[3]}, o[d0], 0, 0, 0);   \
        o[d0] = __builtin_amdgcn_mfma_f32_32x32x16_bf16(pa3, (bf16x8){l3[0], l3[1], l3[2], l3[3], h3[0], h3[1], h3[2], h3[3]}, o[d0], 0, 0, 0); } while (0)
    PV_D0(0); PV_D0(1); PV_D0(2); PV_D0(3);
#undef PV_D0
#undef TRRD
}
struct Bases { __amdgpu_buffer_rsrc_t rs; unsigned Q, K, V, O, KR; };
struct BlockRef { unsigned qoff, kvoff, kroff; int P0; };
struct Seam { bf16x8 qr[8]; bf16x8 st0, st1; float st_kx; };
#define VMW() asm volatile("s_waitcnt vmcnt(0)" ::: "memory")
#define VMWN(n) asm volatile("s_waitcnt vmcnt(%0)" :: "i"(n) : "memory")
#define BLD8(soff, voff) __builtin_bit_cast(bf16x8, __builtin_amdgcn_raw_buffer_load_b128(B.rs, (int)(voff), (int)(soff), 0))
#define SLOAD_K(kbase, krbase, k0) do { const unsigned so__ = (kbase) + (unsigned)(k0) * (LD * 2u); S.st0 = BLD8(so__, kvo0); S.st1 = BLD8(so__, kvo1); \
                         if (wid == 0) S.st_kx = __builtin_bit_cast(float, __builtin_amdgcn_raw_buffer_load_b32(B.rs, lane * 4, (int)((krbase) + (unsigned)(k0) * 4u), 0)); } while (0)
#define SLOAD_V(vbase, k0) do { const unsigned so__ = (vbase) + (unsigned)(k0) * (LD * 2u); S.st0 = BLD8(so__, kvo0); S.st1 = BLD8(so__, kvo1); } while (0)
#define SWRITE_K(bf) do { *(bf16x8*)(K_lds + (bf) * SHM_K + kws) = S.st0; *(bf16x8*)(K_lds + (bf) * SHM_K + kws + 32 * 256) = S.st1; \
                           if (wid == 0) *(float*)(KX_lds + (bf) * SHM_KX + lane * 4) = S.st_kx; } while (0)
#define SWRITE_V(bf) do { *(bf16x8*)(V_lds + (bf) * SHM_V + vst0) = S.st0; *(bf16x8*)(V_lds + (bf) * SHM_V + vst1) = S.st1; } while (0)
#define QLOADS(qbase) do { const unsigned qo__ = (unsigned)(r32 * LD + hi * 8) * 2u; const unsigned so__ = (qbase) + (unsigned)(wid * QBLK) * (LD * 2u); \
                         _Pragma("unroll") for (int d0 = 0; d0 < 8; ++d0) S.qr[d0] = BLD8(so__, qo__ + d0 * 32); } while (0)
__device__ __forceinline__ void prime(const int tid, const Bases& B, const BlockRef& cur, char* lds, Seam& S) {
    const int wid = __builtin_amdgcn_readfirstlane(tid >> 6), r32 = tid & 31, hi = (tid >> 5) & 1;
    const int sr = tid >> 4, sc = (tid & 15) * 8, kws = KSWZ(sr, sc * 2); char* K_lds = lds + OFF_K; char* KX_lds = lds + OFF_KX;
    const unsigned kvo0 = (unsigned)(sr * LD + sc) * 2u, kvo1 = kvo0 + 32u * LD * 2u;
    const int lane = tid & 63;
    QLOADS(B.Q + cur.qoff);
    SLOAD_K(B.K + cur.kvoff, B.KR + cur.kroff, 0); VMW(); SWRITE_K(0); SBAR(); SLOAD_V(B.V + cur.kvoff, 0);
    __syncthreads();
}
__device__ __forceinline__ void block(const int tid, const Bases& B, const BlockRef& cur, const BlockRef& nxt, char* lds, Seam& S) {
    const int wid = __builtin_amdgcn_readfirstlane(tid >> 6), lane = tid & 63, r32 = lane & 31, hi = lane >> 5;
    const int NT = (cur.P0 + QB - 1) / KVBLK + 1;
    const int qlo = cur.P0 + wid * QBLK, qm = qlo + r32 - 4 * hi;
    char* V_lds = lds; char* K_lds = lds + OFF_K; char* KX_lds = lds + OFF_KX;
    float* ws = (float*)(lds + OFF_WS) + wid * 64; float* li_l = ws, * al_l = ws + 32;
    float m_reg = -1e30f, l_reg = 0; f32x16 o[4] = {};
    const int sr = tid >> 4, sc = (tid & 15) * 8, vst0 = v_st(sr, sc), vst1 = v_st(32 + sr, sc), kws = KSWZ(sr, sc * 2);
    const int vb0 = (int)(uintptr_t)V_lds + v_rd_base(lane);
    const unsigned kvo0 = (unsigned)(sr * LD + sc) * 2u, kvo1 = kvo0 + 32u * LD * 2u;
    const unsigned Kh = B.K + cur.kvoff, Vh = B.V + cur.kvoff, KRh = B.KR + cur.kroff;
#define RESC(a) do { if (__any((a) < 1.f)) { if (hi == 0) al_l[r32] = (a); asm volatile("s_waitcnt lgkmcnt(0)" ::: "memory");              \
                     for (int d_ = 0; d_ < 4; ++d_) for (int r = 0; r < 16; ++r) o[d_][r] *= al_l[crow(r, hi)]; } } while (0)
#define KBASE(t) ((t) * KVBLK)
#define MASKT(P0_, P1_, t) do { const int kb_ = KBASE(t); if (kb_ + KVBLK - 1 > qlo) mask_tile(P0_, P1_, qm - kb_); } while (0)
    constexpr int NQL = 8;
#define SEAM_K0() do { VMWN(NQL); SWRITE_K(0); SBAR(); SLOAD_V(B.V + nxt.kvoff, 0); SBAR(); } while (0)
    f32x16 pA0, pA1, pB0, pB1; float mnA, mnB, alA, alB; bf16x8 pa0, pa1, pa2, pa3;
    VMW(); SWRITE_V(0); SBAR();
    if (NT > 1) { SLOAD_K(Kh, KRh, KBASE(1)); }
    SBAR(); qkt<0>(pA0, pA1, lds, r32, hi, S.qr);
    if (NT > 1) { VMW(); SWRITE_K(1); SBAR(); SLOAD_V(Vh, KBASE(1)); }
    MASKT(pA0, pA1, 0); partialSM(pA0, pA1, m_reg, mnA, alA);
    if (NT > 1) { VMW(); SWRITE_V(1); SBAR(); if (NT > 2) SLOAD_K(Kh, KRh, KBASE(2)); }
    __syncthreads();
#define HALF_STEP(PX0, PX1, mnX, alX, PY0, PY1, alY, t, KB, VB, SB) do {                                                      \
        SBAR(); qkt<KB>(PX0, PX1, lds, r32, hi, S.qr);                                             \
        finishSM(PY0, PY1, alY, l_reg, pa0, pa1, pa2, pa3); SBAR();                                                           \
        if ((t) + 1 < NT) { VMW(); SWRITE_K(SB); SBAR(); SLOAD_V(Vh, KBASE((t) + 1)); } SBAR();                              \
        pv_tile<VB>(o, vb0, pa0, pa1, pa2, pa3); MASKT(PX0, PX1, (t)); partialSM(PX0, PX1, m_reg, mnX, alX);                                        \
        __syncthreads();                                                                                                      \
        if ((t) + 1 < NT) { VMW(); SWRITE_V(SB); SBAR(); if ((t) + 2 < NT) SLOAD_K(Kh, KRh, KBASE((t) + 2)); }              \
        RESC(alX); __syncthreads(); } while (0)
    for (int t = 1; t + 1 < NT; t += 2) {
        HALF_STEP(pB0, pB1, mnB, alB, pA0, pA1, alA, t, 1, 0, 0);
        HALF_STEP(pA0, pA1, mnA, alA, pB0, pB1, alB, t + 1, 0, 1, 1);
    }
    const bool even = (NT & 1) == 0;
    if (even) { SBAR(); qkt<1>(pB0, pB1, lds, r32, hi, S.qr); SBAR(); }
    SLOAD_K(B.K + nxt.kvoff, B.KR + nxt.kroff, 0); SBAR();
    QLOADS(B.Q + nxt.qoff);
    SBAR();
    finishSM(pA0, pA1, alA, l_reg, pa0, pa1, pa2, pa3); SBAR();
    pv_tile<0>(o, vb0, pa0, pa1, pa2, pa3);
    if (even) { MASKT(pB0, pB1, NT - 1); partialSM(pB0, pB1, m_reg, mnB, alB); __syncthreads(); RESC(alB);
        finishSM(pB0, pB1, alB, l_reg, pa0, pa1, pa2, pa3); SBAR(); pv_tile<1>(o, vb0, pa0, pa1, pa2, pa3); }
    SBAR(); SEAM_K0();
    if (hi == 0) li_l[r32] = l_reg; asm volatile("s_waitcnt lgkmcnt(0)" ::: "memory");
    float rli[16];
#pragma unroll
    for (int r = 0; r < 16; ++r) rli[r] = __builtin_amdgcn_rcpf(li_l[crow(r, hi)]);
    const unsigned Ow = B.O + cur.qoff + (unsigned)(wid * QBLK) * (LD * 2u);
    const unsigned oo = (unsigned)(4 * hi * LD + r32) * 2u;
#pragma unroll
    for (int r = 0; r < 16; ++r) { const unsigned ro = oo + (unsigned)(((r & 3) + 8 * (r >> 2)) * LD) * 2u;
#pragma unroll
        for (int d0 = 0; d0 < 4; ++d0) { const float v = o[d0][r] * rli[r];
            const float vn = __shfl_xor(v, 1);
            if ((r32 & 1) == 0) __builtin_amdgcn_raw_buffer_store_b32(cvtpk(v, vn), B.rs, (int)(ro + d0 * 64), (int)Ow, 0); } }
    __syncthreads();
#undef RESC
#undef KBASE
#undef MASKT
#undef SEAM_K0
#undef HALF_STEP
}
#undef BLD8
#undef VMW
#undef VMWN
#undef SLOAD_K
#undef SLOAD_V
#undef SWRITE_K
#undef SWRITE_V
#undef QLOADS
#undef KSWZ
#undef SBAR

__device__ __forceinline__ BlockRef make_ref(int L, int pass) {
    const int bh = L >> 4, x = L & 15, qb = pass ? 31 - x : x, b = bh >> 4, h = bh & 15;
    BlockRef r; r.P0 = qb * QB;
    r.kvoff = ((unsigned)(b * SEQ) * LD + h * D) * 2u; r.qoff = r.kvoff + (unsigned)r.P0 * (LD * 2u); r.kroff = (unsigned)bh * SEQ * 4u;
    return r;
}
__device__ __forceinline__ void attn_phase(const int tid, char* lds, unsigned char* ws, unsigned offQ, unsigned offK, unsigned offV, unsigned offO, unsigned offKR, int vcu, int G) {
    const int total = 32 * 16;
    int L = vcu; if (L >= total) return;
    int pass = 0;
    const Bases B{__builtin_amdgcn_make_buffer_rsrc((void*)ws, 0, 0x7FFFFFFF, 0x00020000), offQ, offK, offV, offO, offKR};
    BlockRef cur = make_ref(L, 0);
    Seam S;
    prime(tid, B, cur, lds, S);
    for (;;) {
        const bool more_pass = pass == 0, more_item = L + G < total, last = !more_pass && !more_item;
        int passn = pass + 1, Ln = L;
        if (!more_pass) { passn = 0; Ln = more_item ? L + G : L; }
        const BlockRef nxt = last ? cur : make_ref(Ln, passn);
        block(tid, B, cur, nxt, lds, S);
        if (last) break;
        cur = nxt; pass = passn; L = Ln;
    }
}
}

#define GAS __attribute__((address_space(1)))
#define LAS __attribute__((address_space(3)))
#define XB_TMO      128
#define XB_XCNT(j)  (256  + 64 * (j))
#define XB_XSUB(j)  (1280 + 64 * (j))
#define XB_XGEN(j)  (2304 + 64 * (j))
#define XB_TOP      3328
#define XB_TOPGEN   3392
#define XCD_BAR_WORDS 3456
#define XB_SPIN_CAP (1u << 18)
typedef GAS unsigned gu32_t;
__device__ __forceinline__ unsigned xb_ld(gu32_t* p)              { return __hip_atomic_load(p, __ATOMIC_RELAXED, __HIP_MEMORY_SCOPE_AGENT); }
__device__ __forceinline__ unsigned xb_add(gu32_t* p, unsigned v) { return __hip_atomic_fetch_add(p, v, __ATOMIC_RELAXED, __HIP_MEMORY_SCOPE_AGENT); }
__device__ __forceinline__ unsigned xb_xcc_id() { return (unsigned)__builtin_amdgcn_s_getreg((3 << 11) | 20) & 0xFu; }
#define XB_SPIN(cond, bar) do { unsigned _sp = 0; while (cond) { __builtin_amdgcn_s_sleep(1); \
    if ((++_sp & 255u) == 0u) { if (xb_ld(&(bar)[XB_TMO])) break; if (_sp > XB_SPIN_CAP) { (void)xb_add(&(bar)[XB_TMO], 1u); break; } } } } while (0)
struct XcdBarrier { unsigned* bar; unsigned x; volatile LAS unsigned* st; };
__device__ __forceinline__ XcdBarrier xcd_barrier_post(unsigned* bar, volatile LAS unsigned* st) {
    XcdBarrier b; b.bar = bar; b.x = xb_xcc_id(); b.st = st;
    if (threadIdx.x == 0) (void)xb_add((gu32_t*)&bar[XB_XCNT(b.x)], 1u);
    return b;
}
__device__ __forceinline__ void xcd_barrier_complete(gu32_t* bar, unsigned x, unsigned& nloc, unsigned& nx) {
    const unsigned G = gridDim.x * gridDim.y * gridDim.z;
    unsigned sum, cnt, mine, sp = 0u;
    for (;;) {
        sum = 0u; cnt = 0u; mine = 0u;
#pragma unroll
        for (unsigned j = 0; j < 16; ++j) { const unsigned c = xb_ld(&bar[XB_XCNT(j)]); sum += c; cnt += (c > 0u) ? 1u : 0u; mine = (j == x) ? c : mine; }
        if (sum == G) break;
        __builtin_amdgcn_s_sleep(1);
        if ((++sp & 255u) == 0u) { if (xb_ld(&bar[XB_TMO])) break; if (sp > XB_SPIN_CAP) { (void)xb_add(&bar[XB_TMO], 1u); break; } }
    }
    nloc = mine > 0u ? mine : 1u; nx = cnt > 0u ? cnt : 1u;
}
__device__ __forceinline__ void xcd_barrier(const XcdBarrier& b) {
    asm volatile("s_waitcnt vmcnt(0)" ::: "memory");
    __syncthreads();
    if (threadIdx.x == 0) {
        unsigned* bar_ = b.bar;
        asm volatile("" : "+s"(bar_));
        gu32_t* bar = (gu32_t*)bar_;
        __builtin_amdgcn_s_waitcnt(0);
        unsigned nloc = b.st[0], nx = b.st[1];
        if (nloc == 0u) { xcd_barrier_complete(bar, b.x, nloc, nx); b.st[0] = nloc; b.st[1] = nx; }
        const unsigned old = xb_add(&bar[XB_XSUB(b.x)], 1u);
        const unsigned gen = old / nloc;
        if (old + 1u == (gen + 1u) * nloc) {
            __builtin_amdgcn_fence(__ATOMIC_RELEASE, "agent");
            asm volatile("s_waitcnt vmcnt(0)" ::: "memory");
            const unsigned og = xb_add(&bar[XB_TOP], 1u);
            const unsigned tg = og / nx;
            if (og + 1u == (tg + 1u) * nx) xb_add(&bar[XB_TOPGEN], 1u);
            else XB_SPIN(xb_ld(&bar[XB_TOPGEN]) == tg, bar);
            __builtin_amdgcn_fence(__ATOMIC_ACQUIRE, "agent");
            xb_add(&bar[XB_XGEN(b.x)], 1u);
            asm volatile("s_waitcnt vmcnt(0)" ::: "memory");
        } else {
            XB_SPIN(xb_ld(&bar[XB_XGEN(b.x)]) == gen, bar);
            __builtin_amdgcn_fence(__ATOMIC_ACQUIRE, "agent");
            asm volatile("s_waitcnt vmcnt(0)" ::: "memory");
        }
    }
    __syncthreads();
}

constexpr int LDS_PHASE = 0;
constexpr int LDS_CTL = 131072;
constexpr int LDS_MISC = 131072 + 4096;
constexpr int LDS_BYTES = 147456;
static_assert(WS_V - WS_K == WS_K - WS_Q, "Q|K|V equally spaced");
static_assert(RP_CTL == LDS_CTL && fox::LDS_BYTES <= LDS_CTL && pg8::STAGE_BYTES <= LDS_CTL, "LDS map");

__device__ __forceinline__ void transpose_item(const float* W, int ldw, int k0, int n0, bf16_t* WT, int ldk, int drow0, LAS float* scr, int lane) {
#pragma unroll 8
    for (int i = 0; i < 32; ++i) { const int kk = 2 * i + (lane >> 5); scr[kk * 33 + (lane & 31)] = W[(size_t)(k0 + kk) * ldw + n0 + (lane & 31)]; }
    asm volatile("s_waitcnt lgkmcnt(0)" ::: "memory");
    const int c = lane & 7;
#pragma unroll
    for (int j = 0; j < 4; ++j) { const int n = (lane >> 3) + 8 * j; const LAS float* s = scr + (8 * c) * 33 + n;
        u32x4 o; o.x = pk2(s[0 * 33], s[1 * 33]); o.y = pk2(s[2 * 33], s[3 * 33]); o.z = pk2(s[4 * 33], s[5 * 33]); o.w = pk2(s[6 * 33], s[7 * 33]);
        *(u32x4*)(WT + (size_t)(drow0 + n) * ldk + k0 + 8 * c) = o; }
    asm volatile("s_waitcnt lgkmcnt(0)" ::: "memory");
}
struct Ptrs {
    const float *x, *c, *ada_w, *ada_b, *fox_w_in, *fox_b_f, *fox_w_o, *pool_w, *pool_scale, *router_w, *router_b, *w_gate, *w_up, *w_down, *ln_g, *ln_b;
    float* out; unsigned char* ws;
};
__device__ __forceinline__ void ada_item(const Ptrs& P, int item, float* mods, LAS float* lds_f, int tid) {
    const int lane = tid & 63, wave = tid >> 6;
    LAS float* cs = lds_f;
    LAS float* red = lds_f + 4096;
    for (int idx = tid; idx < 2 * DM; idx += 512) cs[idx] = silu_f(P.c[idx]);
    __syncthreads();
    const int i = item / 64, n0 = (item % 64) * 192;
    f32x4 a0 = (f32x4){0.f, 0.f, 0.f, 0.f}, a1 = a0;
    if (lane < 48) {
        const float* w = P.ada_w + (size_t)i * DM * 6 * DM + n0 + lane * 4;
        const int k0 = wave * 256;
#pragma unroll 8
        for (int k = 0; k < 256; ++k) { const f32x4 wv = *(const f32x4*)(w + (size_t)(k0 + k) * 6 * DM); a0 += wv * cs[k0 + k]; a1 += wv * cs[DM + k0 + k]; }
#pragma unroll
        for (int q = 0; q < 4; ++q) { red[(wave * 2 + 0) * 192 + lane * 4 + q] = a0[q]; red[(wave * 2 + 1) * 192 + lane * 4 + q] = a1[q]; }
    }
    __syncthreads();
    if (tid < 384) { const int b = tid / 192, n = tid % 192; float s = 0.f;
#pragma unroll
        for (int w8 = 0; w8 < 8; ++w8) s += red[(w8 * 2 + b) * 192 + n];
        mods[((size_t)i * 2 + b) * 6 * DM + n0 + n] = s + P.ada_b[(size_t)i * 6 * DM + n0 + n]; }
    __syncthreads();
}
constexpr int IT_WIN = 2 * 32 * 192, IT_WO = 2 * 32 * 64, IT_POOL = 8 * 8 * 16, IT_G = 64 * 32 * 16, IT_U = IT_G, IT_D = 64 * 8 * 64;
constexpr int IT_TOTAL = IT_WIN + IT_WO + IT_POOL + IT_G + IT_U + IT_D;
__device__ __forceinline__ void transpose_dispatch(const Ptrs& P, int it, LAS float* scr, int lane) {
    unsigned char* ws = P.ws;
    if (it < IT_WIN) { const int j = it / (32 * 192), r = it % (32 * 192), kb = r / 192, nb = r % 192;
        transpose_item(P.fox_w_in + (size_t)j * DM * DIN, DIN, kb * 64, nb * 32, (bf16_t*)(ws + WS_WIN_T) + (size_t)j * 3 * DM * DM, DM, nb * 32, scr, lane); return; }
    it -= IT_WIN;
    if (it < IT_WO) { const int j = it / (32 * 64), r = it % (32 * 64), kb = r / 64, nb = r % 64;
        transpose_item(P.fox_w_o + (size_t)j * DM * DM, DM, kb * 64, nb * 32, (bf16_t*)(ws + WS_WO_T) + (size_t)j * DM * DM, DM, nb * 32, scr, lane); return; }
    it -= IT_WO;
    if (it < IT_POOL) { const int jg = it / (8 * 16), r = it % (8 * 16), kb = r / 16, nb = r % 16;
        transpose_item(P.pool_w + (size_t)jg * PGC * PGC, PGC, kb * 64, nb * 32, (bf16_t*)(ws + WS_POOL_T) + (size_t)jg * PGC * PGC, PGC, nb * 32, scr, lane); return; }
    it -= IT_POOL;
    if (it < IT_G + IT_U) { const int up = it >= IT_G ? 1 : 0; if (up) it -= IT_G;
        const int ie = it / (32 * 16), r = it % (32 * 16), kb = r / 16, nb = r % 16, n0 = nb * 32;
        const float* src = (up ? P.w_up : P.w_gate) + (size_t)ie * DM * DE;
        const int drow = (n0 >> 7) * 256 + (n0 & 127) + (up ? 128 : 0);
        transpose_item(src, DE, kb * 64, n0, (bf16_t*)(ws + WS_W13_T) + (size_t)ie * 1024 * DM, DM, drow, scr, lane); return; }
    it -= IT_G + IT_U;
    { const int ie = it / (8 * 64), r = it % (8 * 64), kb = r / 64, nb = r % 64;
      transpose_item(P.w_down + (size_t)ie * DE * DM, DM, kb * 64, nb * 32, (bf16_t*)(ws + WS_WD_T) + (size_t)ie * DM * DE, DE, nb * 32, scr, lane); }
}
__device__ __forceinline__ void scan_bh_wg(int bh, const float* LOGF, float* F, float* KREC, LAS double* sd, int tid) {
    const int b = bh >> 4, h = bh & 15, lane = tid & 63, wave = tid >> 6;
    const float* src = LOGF + ((size_t)b * SEQ) * 16 + h;
    float v[16]; double s = 0.0;
#pragma unroll
    for (int i = 0; i < 16; ++i) { v[i] = src[(size_t)(tid * 16 + i) * 16]; s += (double)v[i]; }
    double incl = s;
#pragma unroll
    for (int o = 1; o < 64; o <<= 1) { const double y = __shfl_up(incl, o); if (lane >= o) incl += y; }
    if (lane == 63) sd[wave] = incl;
    __syncthreads();
    double run = incl - s;
    for (int w = 0; w < wave; ++w) run += sd[w];
#pragma unroll
    for (int i = 0; i < 16; ++i) {
        const int t = tid * 16 + i;
        run += (double)v[i];
        F[(size_t)bh * SEQ + t] = (float)run;
        KREC[(size_t)bh * SEQ + t] = (float)(run * -1.4426950408889634);
    }
    __syncthreads();
}
__device__ __forceinline__ void pool_d_phase(const bf16_t* H, bf16_t* Dp, int wgid, int G, int tid) {
    for (long idx = (long)wgid * 512 + tid; idx < (long)T * 256; idx += (long)G * 512) {
        const int row = (int)(idx >> 8), c8 = (int)(idx & 255) * 8, t = row % SEQ, g = c8 / PGC, w = 2 << g;
        const int nw = t + 1 < w ? t + 1 : w;
        float s[8], cur[8];
#pragma unroll
        for (int i = 0; i < 8; ++i) { s[i] = 0.f; cur[i] = 0.f; }
        for (int d = 0; d < nw; ++d) {
            const u32x4 a = *(const u32x4*)(H + (size_t)(row - d) * DM + c8);
#pragma unroll
            for (int q = 0; q < 4; ++q) { const float lo = bf2f(a[q] & 0xffffu), hi = bf2f(a[q] >> 16); s[2 * q] += lo; s[2 * q + 1] += hi; if (d == 0) { cur[2 * q] = lo; cur[2 * q + 1] = hi; } }
        }
        const float inv = 1.f / (float)nw; u32x4 o;
#pragma unroll
        for (int q = 0; q < 4; ++q) o[q] = pk2(s[2 * q] * inv - cur[2 * q], s[2 * q + 1] * inv - cur[2 * q + 1]);
        *(u32x4*)(Dp + (size_t)row * DM + c8) = o;
    }
}

#define LTID() ltid_(wave)
__device__ __forceinline__ int ltid_(int wave_s) { int t; asm volatile("v_mbcnt_lo_u32_b32 %0, -1, 0\n\tv_mbcnt_hi_u32_b32 %0, -1, %0" : "=v"(t)); return wave_s * 64 + t; }
constexpr int N_PHASES = 1 + 8 * DEPTH;
struct Args { Ptrs p; int ph_lo, ph_hi; };

__global__ void __launch_bounds__(512, 2) fwd(Args args) {
    extern __shared__ __attribute__((aligned(16))) unsigned char lds[];
    const Ptrs& P = args.p;
    const int wave = __builtin_amdgcn_readfirstlane((int)threadIdx.x >> 6);
    const int G = gridDim.x, bx = blockIdx.x, vcu = (G % 8 == 0) ? (bx % 8) * (G / 8) + bx / 8 : bx;
    unsigned char* ws = P.ws;
    int* ctl = (int*)(ws + WS_CTL); float* mods = (float*)(ws + WS_MODS); float* LOGF = (float*)(ws + WS_LOGF); float* F = (float*)(ws + WS_F);
    float* KREC = (float*)(ws + WS_KREC);
    int* E01 = (int*)(ws + WS_E01); float* W01 = (float*)(ws + WS_W01); int* POS = (int*)(ws + WS_POS); int* TOK = (int*)(ws + WS_TOK);
    bf16_t* XRES = (bf16_t*)(ws + WS_XRES); bf16_t* H = (bf16_t*)(ws + WS_H); bf16_t* Qb = (bf16_t*)(ws + WS_Q); bf16_t* Kb = (bf16_t*)(ws + WS_K); bf16_t* Vb = (bf16_t*)(ws + WS_V);
    bf16_t* Ob = (bf16_t*)(ws + WS_O); bf16_t* Z = (bf16_t*)(ws + WS_Z); bf16_t* HID = (bf16_t*)(ws + WS_HID); bf16_t* OSLOT = (bf16_t*)(ws + WS_OSLOT);
    volatile LAS unsigned* MISC = (volatile LAS unsigned*)((LAS unsigned char*)lds + LDS_MISC);
    if (threadIdx.x < 4) MISC[threadIdx.x] = 0u;
    __syncthreads();
    XcdBarrier bar = xcd_barrier_post((unsigned*)(ctl + CW_BAR), MISC);
    const int lo = args.ph_lo, hi = args.ph_hi;
    bool ran = false;
#define IN(k) (lo <= (k) && (k) < hi)
#define SEAM() do { if (ran) xcd_barrier(bar); ran = true; } while (0)
#define MODP(i, chunk) (mods + (size_t)(i) * 2 * 6 * DM + (size_t)(chunk) * DM)

    if (IN(0)) { SEAM();
        for (int item = bx; item < DEPTH * 64; item += G) ada_item(P, item, mods, (LAS float*)((LAS unsigned char*)lds + LDS_PHASE), LTID());
        LAS float* scr = (LAS float*)((LAS unsigned char*)lds + LDS_PHASE + wave * 8448);
        { const int lane = LTID() & 63;
          for (int it = vcu * 8 + wave; it < IT_TOTAL; it += G * 8) transpose_dispatch(P, it, scr, lane); }
    }
    for (int i = 0; i < DEPTH; ++i) {
        const int base = 1 + 8 * i, j = i >> 1; const bool foxl = (i & 1) == 0;
        int* CNT = ctl + CW_CNT + i * 64;
        if (i == 0 && IN(base + 0)) { SEAM();
            RowP R; R.mode = 0; R.last = 0; R.sk_kind = 1; R.wsk_ld = DIN; R.xin = P.x; R.Z = nullptr; R.XRES = XRES; R.H = H; R.OUT = nullptr; R.OSLOT = nullptr; R.gamma = nullptr; R.beta = nullptr;
            R.sh = MODP(0, 0); R.sc = MODP(0, 1); R.gate = nullptr; R.Wsk = P.fox_w_in + 3 * DM; R.bsk = P.fox_b_f; R.LOGF = LOGF; R.E01 = nullptr; R.W01 = nullptr; R.POS = nullptr; R.CNT = nullptr; R.TOK = nullptr;
            R.pE01 = nullptr; R.pPOS = nullptr; R.pCNT = nullptr;
            row_pass<0>(LTID(), R, lds);
        }
        if (IN(base + 1)) { SEAM();
            if (foxl) {
                if (bx < 32) scan_bh_wg(bx, LOGF, F, KREC, (LAS double*)((LAS unsigned char*)lds + LDS_CTL), LTID());
                pg8::StaticOrder S; S.init(T / 256, 3 * DM / 256, G, bx, 0, DM, DM);
                pg8::EpiQKV E{Qb, (long)((WS_K - WS_Q) / 2)};
                pg8::gemm_phase<pg8::EpiQKV, pg8::StaticOrder, true>(LTID(), (LAS unsigned char*)lds + LDS_PHASE, H, (const bf16_t*)(ws + WS_WIN_T) + (size_t)j * 3 * DM * DM, DM, DM, S, E);
            } else {
                pool_d_phase(H, Qb, bx, G, LTID());
            }
        }
        if (foxl && IN(base + 2)) { SEAM();
            fox::attn_phase(LTID(), (char*)lds + LDS_PHASE, ws, (unsigned)WS_Q, (unsigned)WS_K, (unsigned)WS_V, (unsigned)WS_O, (unsigned)WS_KREC, vcu, G);
        }
        if ((foxl && IN(base + 3)) || (!foxl && IN(base + 2))) { SEAM();
            pg8::StaticOrder S; S.init(T / 256, DM / 256, G, bx, foxl ? 0 : 1, DM, foxl ? DM : PGC);
            pg8::EpiRes E{Z, XRES, MODP(i, 2), foxl ? nullptr : P.pool_scale + (size_t)j * DM};
            const bf16_t* A = foxl ? Ob : Qb;
            const bf16_t* Bt = foxl ? (const bf16_t*)(ws + WS_WO_T) + (size_t)j * DM * DM : (const bf16_t*)(ws + WS_POOL_T) + (size_t)j * NPG * PGC * PGC;
            pg8::gemm_phase<pg8::EpiRes, pg8::StaticOrder, true>(LTID(), (LAS unsigned char*)lds + LDS_PHASE, A, Bt, foxl ? DM : PGC, foxl ? DM : PGC, S, E);
        }
        if (IN(base + 4)) { SEAM();
            RowP R; R.mode = 1; R.last = 0; R.sk_kind = 2; R.wsk_ld = NE; R.xin = nullptr; R.Z = Z; R.XRES = XRES; R.H = H; R.OUT = nullptr; R.OSLOT = nullptr;
            R.gamma = P.ln_g + (size_t)(i * 2 + 0) * DM; R.beta = P.ln_b + (size_t)(i * 2 + 0) * DM; R.sh = MODP(i, 3); R.sc = MODP(i, 4); R.gate = nullptr;
            R.Wsk = P.router_w; R.bsk = P.router_b; R.LOGF = nullptr; R.E01 = E01; R.W01 = W01; R.POS = POS; R.CNT = CNT; R.TOK = TOK; R.pE01 = nullptr; R.pPOS = nullptr; R.pCNT = nullptr;
            row_pass<1>(LTID(), R, lds);
        }
        if (IN(base + 5) || IN(base + 6)) {
        }
        if (IN(base + 5)) { SEAM();
            int* tp = (int*)(lds + LDS_CTL);
            if (LTID() == 0) { int acc = 0; for (int e = 0; e < 16; ++e) { tp[e] = acc; acc += (CNT[e] + 255) >> 8; } tp[16] = acc; }
            __syncthreads();
            pg8::MoeOrder S; S.tp = tp; S.cnt = CNT; S.TOK = TOK; S.npn = 4; S.G = G; S.c = vcu; S.m1 = 1; S.lda = DM;
            pg8::EpiGU E{HID, TOK, W01};
            pg8::gemm_phase<pg8::EpiGU, pg8::MoeOrder, true>(LTID(), (LAS unsigned char*)lds + LDS_PHASE, H, (const bf16_t*)(ws + WS_W13_T) + (size_t)i * NE * 1024 * DM, DM, DM, S, E);
        }
        if (IN(base + 6)) { SEAM();
            int* tp = (int*)(lds + LDS_CTL);
            if (LTID() == 0) { int acc = 0; for (int e = 0; e < 16; ++e) { tp[e] = acc; acc += (CNT[e] + 255) >> 8; } tp[16] = acc; }
            __syncthreads();
            pg8::MoeOrder S; S.tp = tp; S.cnt = CNT; S.TOK = TOK; S.npn = 8; S.G = G; S.c = vcu; S.m1 = 0; S.lda = DE;
            pg8::EpiDown E{OSLOT};
            pg8::gemm_phase<pg8::EpiDown, pg8::MoeOrder, true>(LTID(), (LAS unsigned char*)lds + LDS_PHASE, HID, (const bf16_t*)(ws + WS_WD_T) + (size_t)i * NE * DM * DE, DE, DE, S, E);
        }
        if (IN(base + 7)) { SEAM();
            RowP R; R.mode = 2; R.last = (i == DEPTH - 1) ? 1 : 0; R.sk_kind = 0; R.wsk_ld = DIN; R.xin = nullptr; R.Z = nullptr; R.XRES = XRES; R.H = H; R.OUT = P.out; R.OSLOT = OSLOT;
            R.gamma = P.ln_g + (size_t)(i * 2 + 1) * DM; R.beta = P.ln_b + (size_t)(i * 2 + 1) * DM; R.gate = MODP(i, 5);
            R.sh = MODP((i + 1) & 3, 0); R.sc = MODP((i + 1) & 3, 1); R.Wsk = nullptr; R.bsk = nullptr; R.LOGF = LOGF;
            if (i + 1 < DEPTH && ((i + 1) & 1) == 0) { const int jn = (i + 1) >> 1; R.sk_kind = 1; R.Wsk = P.fox_w_in + (size_t)jn * DM * DIN + 3 * DM; R.bsk = P.fox_b_f + (size_t)jn * NH; }
            R.E01 = nullptr; R.W01 = nullptr; R.POS = nullptr; R.CNT = nullptr; R.TOK = nullptr; R.pE01 = E01; R.pPOS = POS; R.pCNT = CNT;
            row_pass<2>(LTID(), R, lds);
        }
    }
#undef IN
#undef SEAM
#undef MODP
}

#ifndef MK_PER_PHASE
#define MK_PER_PHASE 0
#endif
extern "C" void kernel_launch(void* const* d_in, const int* in_sizes, int n_in, void* d_out, int out_size, void* d_ws, size_t ws_size, hipStream_t stream) {
    static int grid = 0;
    if (grid == 0) {
        if (ws_size < WS_END || n_in != 16) { fprintf(stderr, "kernel_launch: need %zu bytes of workspace and 16 inputs (got %zu, %d)\n", (size_t)WS_END, ws_size, n_in); grid = -1; return; }
        int dev = 0, cus = 0, per_cu = 0;
        (void)hipGetDevice(&dev); (void)hipDeviceGetAttribute(&cus, hipDeviceAttributeMultiprocessorCount, dev);
        (void)hipFuncSetAttribute((const void*)fwd, hipFuncAttributeMaxDynamicSharedMemorySize, LDS_BYTES);
        if (hipOccupancyMaxActiveBlocksPerMultiprocessor(&per_cu, (const void*)fwd, 512, LDS_BYTES) != hipSuccess || per_cu < 1) fprintf(stderr, "kernel_launch: occupancy query reports %d blocks per CU\n", per_cu);
        (void)hipGetLastError();
        grid = cus > 0 ? cus : 256;
    }
    if (grid < 0) return;
    (void)hipMemsetAsync((char*)d_ws + WS_CTL, 0, CTL_BYTES, stream);
    Args a; memset(&a, 0, sizeof(a));
    const float** pp = (const float**)&a.p;
    for (int i = 0; i < 16; ++i) pp[i] = (const float*)d_in[i];
    a.p.out = (float*)d_out; a.p.ws = (unsigned char*)d_ws;
#if MK_PER_PHASE
    for (int ph = 0; ph < N_PHASES; ++ph) {
        if (ph >= 1) { const int i = (ph - 1) / 8, s = (ph - 1) % 8; if (s == 0 && i != 0) continue; if ((i & 1) && s == 3) continue; }
        a.ph_lo = ph; a.ph_hi = ph + 1;
        hipLaunchKernelGGL(fwd, dim3(grid), dim3(512), LDS_BYTES, stream, a);
    }
#else
    a.ph_lo = 0; a.ph_hi = N_PHASES;
    hipLaunchKernelGGL(fwd, dim3(grid), dim3(512), LDS_BYTES, stream, a);
#endif
    (void)in_sizes; (void)out_size;
}
```
